# Optimizing an MI355X kernel written in HIP

```python
import math
import jax
import jax.numpy as jnp
from jax import lax
import numpy as np


D_MODEL = 2048
BATCH = 4
SEQ = 2048
DEPTH = 1

RET_QK_DIM = 128
RET_V_DIM = 256
RET_HEADS = D_MODEL // RET_V_DIM
RET_QK_WIDTH = RET_HEADS * RET_QK_DIM
RET_WIDTH = RET_HEADS * RET_V_DIM
CHUNK = 128

DIFF_HEAD_DIM = 128
DIFF_V_DIM = 2 * DIFF_HEAD_DIM
DIFF_HEADS = D_MODEL // DIFF_V_DIM
DIFF_QK_WIDTH = DIFF_HEADS * 2 * DIFF_HEAD_DIM
DIFF_WIDTH = DIFF_HEADS * DIFF_V_DIM
Q_BLOCK = 128
ROPE_THETA = 10000.0

NORM_EPS = 1e-6
SUBLN_EPS = 1e-5

SPLIT_SIZES = (RET_QK_WIDTH, RET_QK_WIDTH, RET_WIDTH, RET_WIDTH,
               DIFF_QK_WIDTH, DIFF_QK_WIDTH, DIFF_WIDTH, DIFF_WIDTH,
               D_MODEL, D_MODEL)
SPLIT_POINTS = tuple(int(v) for v in np.cumsum(SPLIT_SIZES)[:-1])
IN_WIDTH = int(sum(SPLIT_SIZES))

kernel_name = 'hybrid_retention_diffattn_gated_block'


def rmsnorm(x, w, eps):
    xf = x.astype(jnp.float32)
    y = xf * lax.rsqrt(jnp.mean(xf * xf, axis=-1, keepdims=True) + eps)
    if w is not None:
        y = y * w.astype(jnp.float32)
    return y.astype(x.dtype)


def rotary_tables(pos, inv_freq, dtype):
    ang = pos[:, None] * inv_freq[None, :]
    emb = jnp.concatenate([ang, ang], axis=-1)
    return jnp.cos(emb).astype(dtype)[:, None, :], jnp.sin(emb).astype(dtype)[:, None, :]


def rotate_half(x):
    x1, x2 = jnp.split(x, 2, axis=-1)
    return jnp.concatenate([-x2, x1], axis=-1)


def apply_rotary(x, cos, sin):
    return x * cos + rotate_half(x) * sin


def retention(q, k, v):
    b, s, h, dk = q.shape
    dv = v.shape[-1]
    n = s // CHUNK
    log_gamma = jnp.log1p(-jnp.exp2(-5.0 - jnp.arange(h, dtype=jnp.float32)))
    qc = q.reshape(b, n, CHUNK, h, dk)
    kc = k.reshape(b, n, CHUNK, h, dk)
    vc = v.reshape(b, n, CHUNK, h, dv)
    idx = jnp.arange(CHUNK, dtype=jnp.float32)
    rel = idx[:, None] - idx[None, :]
    decay_mask = jnp.where(rel >= 0.0,
                           jnp.exp(log_gamma[:, None, None] * jnp.maximum(rel, 0.0)[None]),
                           0.0)
    scores = jnp.einsum('bnqhd,bnkhd->bnhqk', qc, kc) * decay_mask
    o_intra = jnp.einsum('bnhqk,bnkhe->bnqhe', scores, vc)
    zeta = jnp.exp(log_gamma[None, :] * (CHUNK - 1.0 - idx)[:, None])
    kv = jnp.einsum('bnkhd,bnkhe->bnhde', kc, vc * zeta[:, :, None])
    chunk_decay = jnp.exp(log_gamma * CHUNK)[:, None, None]

    def step(state, kv_i):
        return state * chunk_decay + kv_i, state

    init = jnp.zeros((b, h, dk, dv), kv.dtype)
    _, prev = lax.scan(step, init, jnp.moveaxis(kv, 1, 0))
    prev = jnp.moveaxis(prev, 0, 1)
    xi = jnp.exp(log_gamma[None, :] * (idx + 1.0)[:, None])
    o_cross = jnp.einsum('bnqhd,bnhde->bnqhe', qc, prev) * xi[:, :, None]
    return (o_intra + o_cross).reshape(b, s, h, dv)


def diff_attention(q, k, v, lam):
    b, s, h, _, d = q.shape
    n = s // Q_BLOCK
    qb = (q * (d ** -0.5)).reshape(b, n, Q_BLOCK, h, 2, d)
    qb = jnp.moveaxis(qb, 1, 0)
    key_pos = jnp.arange(s)

    def block(args):
        q_blk, i = args
        q_pos = i * Q_BLOCK + jnp.arange(Q_BLOCK)
        scores = jnp.einsum('bqhcd,bkhcd->bhcqk', q_blk, k).astype(jnp.float32)
        causal = key_pos[None, :] <= q_pos[:, None]
        scores = jnp.where(causal, scores, -jnp.inf)
        probs = jax.nn.softmax(scores, axis=-1)
        attn = probs[:, :, 0] - lam * probs[:, :, 1]
        return jnp.einsum('bhqk,bkhe->bqhe', attn.astype(v.dtype), v)

    out = lax.map(block, (qb, jnp.arange(n)))
    return jnp.moveaxis(out, 0, 1).reshape(b, s, h, 2 * d)


def setup_inputs(seed: int = 0) -> dict:
    key = jax.random.key(seed)
    ks = jax.random.split(key, 12)
    f32 = jnp.float32
    x = jax.random.normal(ks[0], (BATCH, SEQ, D_MODEL), f32)
    norm_w = 1.0 + 0.02 * jax.random.normal(ks[1], (DEPTH, D_MODEL), f32)
    w_in = jax.random.normal(ks[2], (DEPTH, D_MODEL, IN_WIDTH), f32) * D_MODEL ** -0.5
    w_ret_up = jax.random.normal(ks[3], (DEPTH, RET_WIDTH, D_MODEL), f32) * RET_WIDTH ** -0.5
    w_diff_up = jax.random.normal(ks[4], (DEPTH, DIFF_WIDTH, D_MODEL), f32) * DIFF_WIDTH ** -0.5
    w_out = jax.random.normal(ks[5], (DEPTH, D_MODEL, D_MODEL), f32) * D_MODEL ** -0.5
    lambda_q1 = 0.1 * jax.random.normal(ks[6], (DEPTH, DIFF_HEAD_DIM), f32)
    lambda_k1 = 0.1 * jax.random.normal(ks[7], (DEPTH, DIFF_HEAD_DIM), f32)
    lambda_q2 = 0.1 * jax.random.normal(ks[8], (DEPTH, DIFF_HEAD_DIM), f32)
    lambda_k2 = 0.1 * jax.random.normal(ks[9], (DEPTH, DIFF_HEAD_DIM), f32)
    subln_w = 1.0 + 0.02 * jax.random.normal(ks[10], (DEPTH, DIFF_V_DIM), f32)
    final_norm_w = 1.0 + 0.02 * jax.random.normal(ks[11], (D_MODEL,), f32)
    return {'x': x, 'norm_w': norm_w, 'w_in': w_in, 'w_ret_up': w_ret_up,
            'w_diff_up': w_diff_up, 'w_out': w_out, 'lambda_q1': lambda_q1,
            'lambda_k1': lambda_k1, 'lambda_q2': lambda_q2, 'lambda_k2': lambda_k2,
            'subln_w': subln_w, 'final_norm_w': final_norm_w}


def reference(x, norm_w, w_in, w_ret_up, w_diff_up, w_out, lambda_q1, lambda_k1,
              lambda_q2, lambda_k2, subln_w, final_norm_w):
    b, s, _ = x.shape
    pos = jnp.arange(s, dtype=jnp.float32)
    ret_inv_freq = jnp.exp(-math.log(10000.0) * jnp.linspace(0.0, 1.0, RET_QK_DIM // 2, dtype=jnp.float32))
    rope_inv_freq = ROPE_THETA ** (-jnp.arange(0, DIFF_HEAD_DIM, 2, dtype=jnp.float32) / DIFF_HEAD_DIM)
    ret_cos, ret_sin = rotary_tables(pos, ret_inv_freq, x.dtype)
    rope_cos, rope_sin = rotary_tables(pos, rope_inv_freq, x.dtype)

    h = x
    for l in range(DEPTH):
        xn = rmsnorm(h, norm_w[l], NORM_EPS)
        proj = xn @ w_in[l]
        (rq, rk, rv, rz, dq, dk, dv, dz, g_ret, g_diff) = jnp.split(proj, SPLIT_POINTS, axis=-1)

        rq = apply_rotary(rq.reshape(b, s, RET_HEADS, RET_QK_DIM), ret_cos, ret_sin)
        rk = apply_rotary(rk.reshape(b, s, RET_HEADS, RET_QK_DIM) * (RET_QK_DIM ** -0.5), ret_cos, ret_sin)
        rv = rv.reshape(b, s, RET_HEADS, RET_V_DIM)
        o_ret = retention(rq, rk, rv).astype(h.dtype)
        o_ret = rmsnorm(o_ret, None, NORM_EPS).reshape(b, s, RET_WIDTH)
        o_ret = o_ret * jax.nn.silu(rz)

        dq = apply_rotary(dq.reshape(b, s, 2 * DIFF_HEADS, DIFF_HEAD_DIM), rope_cos, rope_sin)
        dk = apply_rotary(dk.reshape(b, s, 2 * DIFF_HEADS, DIFF_HEAD_DIM), rope_cos, rope_sin)
        dq = dq.reshape(b, s, DIFF_HEADS, 2, DIFF_HEAD_DIM)
        dk = dk.reshape(b, s, DIFF_HEADS, 2, DIFF_HEAD_DIM)
        dv = dv.reshape(b, s, DIFF_HEADS, DIFF_V_DIM)
        lam_init = 0.8 - 0.6 * math.exp(-0.3 * l)
        lam = (jnp.exp(jnp.sum(lambda_q1[l].astype(jnp.float32) * lambda_k1[l].astype(jnp.float32)))
               - jnp.exp(jnp.sum(lambda_q2[l].astype(jnp.float32) * lambda_k2[l].astype(jnp.float32)))
               + lam_init)
        o_diff = diff_attention(dq, dk, dv, lam).astype(h.dtype)
        o_diff = rmsnorm(o_diff, subln_w[l], SUBLN_EPS) * (1.0 - lam_init)
        o_diff = o_diff.reshape(b, s, DIFF_WIDTH) * jax.nn.silu(dz)

        mixed = (jax.nn.sigmoid(g_ret) * (o_ret @ w_ret_up[l])
                 + jax.nn.sigmoid(g_diff) * (o_diff @ w_diff_up[l]))
        h = h + mixed @ w_out[l]

    return rmsnorm(h, final_norm_w, NORM_EPS)
```

```cpp
#include <hip/hip_runtime.h>
#include <hip/hip_cooperative_groups.h>
#include <hip/hip_bf16.h>
#include <cstdio>
#include <cstdint>
namespace cg = cooperative_groups;

#ifndef MODE
#define MODE 0
#endif

constexpr int BATCH = 4, SEQ = 2048, DM = 2048, M = BATCH * SEQ, NIN = 18432;
constexpr float NORM_EPS = 1e-6f, SUBLN_EPS = 1e-5f, LAM_INIT = 0.2f;
constexpr float QK_SCALE = 0.08838834764831845f;

constexpr size_t MiB = 1u << 20;
constexpr size_t WS_CTL = 0;
constexpr size_t WS_COSR = 1 * MiB, WS_SINR = WS_COSR + 512 * 1024, WS_COSD = 2 * MiB, WS_SIND = WS_COSD + 512 * 1024;
constexpr size_t WS_SS = 3 * MiB;
constexpr size_t WS_WRUT = 4 * MiB, WS_WDUT = 12 * MiB, WS_WOUTT = 20 * MiB;
constexpr size_t WS_WINT = 32 * MiB;
constexpr size_t WS_XN = 104 * MiB;
constexpr size_t WS_RQK = 136 * MiB;
constexpr size_t WS_RV = 168 * MiB, WS_SRZ = 200 * MiB, WS_DQ = 232 * MiB, WS_DK = 264 * MiB, WS_DV = 296 * MiB, WS_SDZ = 328 * MiB, WS_SGR = 360 * MiB, WS_SGD = 392 * MiB;
constexpr size_t WS_END = 424 * MiB;
constexpr size_t WS_ORET = 32 * MiB, WS_O1 = 64 * MiB, WS_O2 = 96 * MiB;
constexpr size_t WS_AR = 136 * MiB, WS_AD = 168 * MiB;
constexpr size_t WS_T = 232 * MiB;
constexpr size_t WS_MIX = 296 * MiB;

typedef unsigned short bf16_t;
typedef short bf16x8 __attribute__((ext_vector_type(8)));
typedef float f32x4 __attribute__((ext_vector_type(4)));
typedef float f32x2 __attribute__((ext_vector_type(2)));
typedef unsigned u32x4 __attribute__((ext_vector_type(4)));
typedef unsigned u32x2 __attribute__((ext_vector_type(2)));
#define LAS __attribute__((address_space(3)))

struct Ptrs {
    const float *x, *norm_w, *w_in, *w_ret_up, *w_diff_up, *w_out, *lq1, *lk1, *lq2, *lk2, *subln_w, *final_w;
    float* out; unsigned char* ws;
};

__device__ __forceinline__ unsigned f2bf(float f) { unsigned u = __builtin_bit_cast(unsigned, f); return (u + 0x7fffu + ((u >> 16) & 1u)) >> 16; }
__device__ __forceinline__ unsigned pk2(float lo, float hi) { return f2bf(lo) | (f2bf(hi) << 16); }
__device__ __forceinline__ float bflo(unsigned w) { return __builtin_bit_cast(float, w << 16); }
__device__ __forceinline__ float bfhi(unsigned w) { return __builtin_bit_cast(float, w & 0xffff0000u); }
__device__ __forceinline__ u32x4 pack8f(f32x4 a, f32x4 b) { u32x4 w; w.x = pk2(a[0], a[1]); w.y = pk2(a[2], a[3]); w.z = pk2(b[0], b[1]); w.w = pk2(b[2], b[3]); return w; }
__device__ __forceinline__ void unpack8f(u32x4 w, f32x4& a, f32x4& b) { a = (f32x4){bflo(w.x), bfhi(w.x), bflo(w.y), bfhi(w.y)}; b = (f32x4){bflo(w.z), bfhi(w.z), bflo(w.w), bfhi(w.w)}; }
__device__ __forceinline__ float sigmoidf_(float v) { return __builtin_amdgcn_rcpf(1.0f + __builtin_amdgcn_exp2f(-1.4426950408889634f * v)); }
__device__ __forceinline__ float wave_sum(float v) {
#pragma unroll
    for (int o = 1; o < 64; o <<= 1) v += __shfl_xor(v, o);
    return v;
}

__device__ __forceinline__ void epi_in8(unsigned char* ws, int row, int pn, int lcol, f32x4 a, f32x4 b) {
    const int t = row & (SEQ - 1);
    bf16_t* dst; int col;
    if (pn < 8 || (pn >= 24 && pn < 40)) {
        const bool ret = pn < 8;
        const int g = (lcol & 127) >> 3;
        const float* ct = (const float*)(ws + (ret ? WS_COSR : WS_COSD)) + t * 64 + 4 * g;
        const float* st = (const float*)(ws + (ret ? WS_SINR : WS_SIND)) + t * 64 + 4 * g;
        const f32x4 c = *(const f32x4*)ct, s = *(const f32x4*)st;
        f32x4 o1 = a * c - b * s, o2 = b * c + a * s;
        if (ret) {
            const int h = 2 * (pn & 3) + (lcol >> 7);
            const float l2g = ((const float*)(ws + WS_CTL))[16 + h];
            const float e = (float)(t - 1024) * l2g;
            const float sc = (pn >= 4) ? __builtin_amdgcn_exp2f(-e) * QK_SCALE : __builtin_amdgcn_exp2f(e);
            o1 = o1 * sc; o2 = o2 * sc;
            dst = (bf16_t*)(ws + WS_RQK); col = pn * 256 + lcol;
        } else if (pn < 32) { dst = (bf16_t*)(ws + WS_DQ); col = (pn - 24) * 256 + lcol; }
        else { dst = (bf16_t*)(ws + WS_DK); col = (pn - 32) * 256 + lcol; }
        *(u32x4*)(dst + (size_t)row * 2048 + col) = pack8f(o1, o2);
        return;
    }
    if (pn < 16) { dst = (bf16_t*)(ws + WS_RV); col = (pn - 8) * 256 + lcol; }
    else if (pn < 24) { dst = (bf16_t*)(ws + WS_SRZ); col = (pn - 16) * 256 + lcol;
#pragma unroll
        for (int i = 0; i < 4; ++i) { a[i] = a[i] * sigmoidf_(a[i]); b[i] = b[i] * sigmoidf_(b[i]); } }
    else if (pn < 48) { dst = (bf16_t*)(ws + WS_DV); col = (pn - 40) * 256 + lcol; }
    else if (pn < 56) { dst = (bf16_t*)(ws + WS_SDZ); col = (pn - 48) * 256 + lcol;
#pragma unroll
        for (int i = 0; i < 4; ++i) { a[i] = a[i] * sigmoidf_(a[i]); b[i] = b[i] * sigmoidf_(b[i]); } }
    else { dst = (bf16_t*)(ws + (pn < 64 ? WS_SGR : WS_SGD)); col = ((pn - 56) & 7) * 256 + lcol;
#pragma unroll
        for (int i = 0; i < 4; ++i) { a[i] = sigmoidf_(a[i]); b[i] = sigmoidf_(b[i]); } }
    *(u32x4*)(dst + (size_t)row * 2048 + col) = pack8f(a, b);
}
__device__ __forceinline__ void epi_up1_8(unsigned char* ws, int row, int col, f32x4 a, f32x4 b) {
    f32x4 ga, gb; unpack8f(*(const u32x4*)((const bf16_t*)(ws + WS_SGR) + (size_t)row * 2048 + col), ga, gb);
    float* T = (float*)(ws + WS_T) + (size_t)row * 2048 + col;
    *(f32x4*)T = a * ga; *(f32x4*)(T + 4) = b * gb;
}
__device__ __forceinline__ void epi_up2_8(unsigned char* ws, int row, int col, f32x4 a, f32x4 b) {
    f32x4 ga, gb; unpack8f(*(const u32x4*)((const bf16_t*)(ws + WS_SGD) + (size_t)row * 2048 + col), ga, gb);
    const float* T = (const float*)(ws + WS_T) + (size_t)row * 2048 + col;
    const f32x4 ta = *(const f32x4*)T, tb = *(const f32x4*)(T + 4);
    *(u32x4*)((bf16_t*)(ws + WS_MIX) + (size_t)row * 2048 + col) = pack8f(ta + a * ga, tb + b * gb);
}

__device__ __forceinline__ int win_dst_row(int c) {
    const bool qk = (c < 2048) || (c >= 6144 && c < 10240);
    const int d = c & 127, p = 8 * ((d & 63) >> 2) + 4 * (d >> 6) + (d & 3);
    return qk ? (c & ~127) + p : c;
}
template <bool PERMQK>
__device__ __forceinline__ void p0_transpose_item(const float* W, int K, int N, bf16_t* WT, LAS float* scr, int item, int lane) {
    const int nblk = N / 32, kb = item / nblk, nb = item % nblk, k0 = 64 * kb, n0 = 32 * nb;
#pragma unroll 8
    for (int i = 0; i < 32; ++i) { const int kk = 2 * i + (lane >> 5); scr[kk * 33 + (lane & 31)] = W[(size_t)(k0 + kk) * N + n0 + (lane & 31)]; }
    asm volatile("s_waitcnt lgkmcnt(0)" ::: "memory");
    const int c = lane & 7;
#pragma unroll
    for (int j = 0; j < 4; ++j) { const int n = (lane >> 3) + 8 * j; const LAS float* s = scr + (8 * c) * 33 + n;
        u32x4 o; o.x = pk2(s[0 * 33], s[1 * 33]); o.y = pk2(s[2 * 33], s[3 * 33]); o.z = pk2(s[4 * 33], s[5 * 33]); o.w = pk2(s[6 * 33], s[7 * 33]);
        const int drow = PERMQK ? win_dst_row(n0 + n) : (n0 + n);
        *(u32x4*)(WT + (size_t)drow * K + k0 + 8 * c) = o; }
    asm volatile("s_waitcnt lgkmcnt(0)" ::: "memory");
}
__device__ __forceinline__ void p0_prologue(const Ptrs& P, LAS float* scr, int gw, int NGW, int lane) {
    unsigned char* ws = P.ws;
    constexpr int I_IN = (DM / 64) * (NIN / 32), I_SQ = (DM / 64) * (DM / 32);
    for (int it = gw; it < I_IN + 3 * I_SQ; it += NGW) {
        int r = it;
        if (r < I_IN) { p0_transpose_item<true>(P.w_in, DM, NIN, (bf16_t*)(ws + WS_WINT), scr, r, lane); continue; } r -= I_IN;
        if (r < I_SQ) { p0_transpose_item<false>(P.w_ret_up, DM, DM, (bf16_t*)(ws + WS_WRUT), scr, r, lane); continue; } r -= I_SQ;
        if (r < I_SQ) { p0_transpose_item<false>(P.w_diff_up, DM, DM, (bf16_t*)(ws + WS_WDUT), scr, r, lane); continue; } r -= I_SQ;
        p0_transpose_item<false>(P.w_out, DM, DM, (bf16_t*)(ws + WS_WOUTT), scr, r, lane);
    }
    for (int m = gw; m < M; m += NGW) {
        const f32x4* xr = (const f32x4*)(P.x + (size_t)m * DM) + lane; const f32x4* wr_ = (const f32x4*)P.norm_w + lane;
        f32x4 v[8]; float s = 0.f;
#pragma unroll
        for (int j = 0; j < 8; ++j) { v[j] = xr[64 * j]; s += (v[j][0] * v[j][0] + v[j][1] * v[j][1]) + (v[j][2] * v[j][2] + v[j][3] * v[j][3]); }
        const float rstd = 1.0f / sqrtf(wave_sum(s) * (1.0f / DM) + NORM_EPS);
        u32x2* o8 = (u32x2*)((bf16_t*)(ws + WS_XN) + (size_t)m * DM) + lane;
#pragma unroll
        for (int j = 0; j < 8; ++j) { const f32x4 w = wr_[64 * j]; u32x2 o; o.x = pk2(v[j][0] * rstd * w[0], v[j][1] * rstd * w[1]); o.y = pk2(v[j][2] * rstd * w[2], v[j][3] * rstd * w[3]); o8[64 * j] = o; }
    }
    for (int i = gw * 64 + lane; i < SEQ * 64; i += NGW * 64) {
        const int t = i >> 6, f = i & 63;
#pragma unroll
        for (int which = 0; which < 2; ++which) {
            const double ex = which == 0 ? (double)f / 63.0 : (double)f / 64.0;
            const float inv = (float)exp(-9.210340371976184 * ex);
            const float ang = (float)t * inv;
            const double rev = (double)ang * 0.15915494309189535; const double fr = rev - floor(rev);
            const float a = (float)(fr * 6.283185307179586);
            ((float*)(ws + (which == 0 ? WS_COSR : WS_COSD)))[i] = cosf(a);
            ((float*)(ws + (which == 0 ? WS_SINR : WS_SIND)))[i] = sinf(a);
        }
    }
    if (gw == 0) {
        float* ctl = (float*)(ws + WS_CTL);
        const float s1 = wave_sum(P.lq1[lane] * P.lk1[lane] + P.lq1[lane + 64] * P.lk1[lane + 64]);
        const float s2 = wave_sum(P.lq2[lane] * P.lk2[lane] + P.lq2[lane + 64] * P.lk2[lane + 64]);
        if (lane == 0) ctl[0] = expf(s1) - expf(s2) + LAM_INIT;
        if (lane < 8) ctl[16 + lane] = (float)log2(1.0 - exp2(-5.0 - (double)lane));
    }
}
__device__ __forceinline__ void post_rows(const Ptrs& P, int gw, int NGW, int lane) {
    unsigned char* ws = P.ws;
    const float lam = ((const float*)(ws + WS_CTL))[0];
    const int cw = (lane & 7) * 32;
    for (int m = gw; m < M; m += NGW) {
        const size_t off = (size_t)m * 2048 + lane * 32;
        {
            f32x4 o[8]; float s = 0.f;
#pragma unroll
            for (int j = 0; j < 4; ++j) { unpack8f(*(const u32x4*)((const bf16_t*)(ws + WS_ORET) + off + 8 * j), o[2 * j], o[2 * j + 1]); }
#pragma unroll
            for (int j = 0; j < 8; ++j) s += (o[j][0] * o[j][0] + o[j][1] * o[j][1]) + (o[j][2] * o[j][2] + o[j][3] * o[j][3]);
            s += __shfl_xor(s, 1); s += __shfl_xor(s, 2); s += __shfl_xor(s, 4);
            const float rstd = 1.0f / sqrtf(s * (1.0f / 256.0f) + NORM_EPS);
#pragma unroll
            for (int j = 0; j < 4; ++j) { f32x4 za, zb; unpack8f(*(const u32x4*)((const bf16_t*)(ws + WS_SRZ) + off + 8 * j), za, zb);
                *(u32x4*)((bf16_t*)(ws + WS_AR) + off + 8 * j) = pack8f(o[2 * j] * rstd * za, o[2 * j + 1] * rstd * zb); }
        }
        {
            f32x4 d[8]; float s = 0.f;
#pragma unroll
            for (int j = 0; j < 4; ++j) { f32x4 a1, b1, a2, b2; unpack8f(*(const u32x4*)((const bf16_t*)(ws + WS_O1) + off + 8 * j), a1, b1); unpack8f(*(const u32x4*)((const bf16_t*)(ws + WS_O2) + off + 8 * j), a2, b2);
                d[2 * j] = a1 - a2 * lam; d[2 * j + 1] = b1 - b2 * lam; }
#pragma unroll
            for (int j = 0; j < 8; ++j) s += (d[j][0] * d[j][0] + d[j][1] * d[j][1]) + (d[j][2] * d[j][2] + d[j][3] * d[j][3]);
            s += __shfl_xor(s, 1); s += __shfl_xor(s, 2); s += __shfl_xor(s, 4);
            const float rstd = (1.0f - LAM_INIT) / sqrtf(s * (1.0f / 256.0f) + SUBLN_EPS);
#pragma unroll
            for (int j = 0; j < 4; ++j) { f32x4 za, zb; unpack8f(*(const u32x4*)((const bf16_t*)(ws + WS_SDZ) + off + 8 * j), za, zb);
                const f32x4 wa = *(const f32x4*)(P.subln_w + cw + 8 * j), wb = *(const f32x4*)(P.subln_w + cw + 8 * j + 4);
                *(u32x4*)((bf16_t*)(ws + WS_AD) + off + 8 * j) = pack8f(d[2 * j] * rstd * wa * za, d[2 * j + 1] * rstd * wb * zb); }
        }
    }
}
__device__ __forceinline__ void final_rows(const Ptrs& P, int gw, int NGW, int lane) {
    for (int m = gw; m < M; m += NGW) {
        const float part = ((const float*)(P.ws + WS_SS))[(size_t)m * 32 + (lane & 31)];
        const float tot = wave_sum(part) * 0.5f;
        const float rstd = 1.0f / sqrtf(tot * (1.0f / DM) + NORM_EPS);
        f32x4* hr = (f32x4*)(P.out + (size_t)m * DM) + lane; const f32x4* wr_ = (const f32x4*)P.final_w + lane;
#pragma unroll
        for (int j = 0; j < 8; ++j) { const f32x4 h = hr[64 * j]; hr[64 * j] = h * rstd * wr_[64 * j]; }
    }
}
namespace naive {
__global__ void __launch_bounds__(256) k_prologue(Ptrs P) {
    __shared__ float scr_all[4 * 64 * 33];
    const int lane = threadIdx.x & 63, wave = threadIdx.x >> 6;
    p0_prologue(P, (LAS float*)(scr_all + wave * 64 * 33), blockIdx.x * 4 + wave, gridDim.x * 4, lane);
}
__global__ void __launch_bounds__(512) k_post(Ptrs P) { post_rows(P, blockIdx.x * 8 + (threadIdx.x >> 6), gridDim.x * 8, threadIdx.x & 63); }
__global__ void __launch_bounds__(512) k_final(Ptrs P) { final_rows(P, blockIdx.x * 8 + (threadIdx.x >> 6), gridDim.x * 8, threadIdx.x & 63); }

template <int WHICH>
__global__ void __launch_bounds__(256) k_gemm(Ptrs P, const bf16_t* A, const bf16_t* Bt, int K) {
    __shared__ float As[32][68];
    __shared__ float Bs[32][132];
    const int tid = threadIdx.x, ty = tid >> 4, tx = tid & 15;
    const int m0 = blockIdx.y * 64, n0 = blockIdx.x * 128;
    float acc[4][8];
#pragma unroll
    for (int i = 0; i < 4; ++i)
#pragma unroll
        for (int j = 0; j < 8; ++j) acc[i][j] = 0.f;
    for (int k0 = 0; k0 < K; k0 += 32) {
        { const int r = tid >> 2, ks = (tid & 3) * 8; const u32x4 w = *(const u32x4*)(A + (size_t)(m0 + r) * K + k0 + ks); f32x4 a, b; unpack8f(w, a, b);
#pragma unroll
          for (int j = 0; j < 4; ++j) { As[ks + j][r] = a[j]; As[ks + 4 + j][r] = b[j]; } }
        { const int r = tid >> 1, ks = (tid & 1) * 16;
#pragma unroll
          for (int h = 0; h < 2; ++h) { const u32x4 w = *(const u32x4*)(Bt + (size_t)(n0 + r) * K + k0 + ks + 8 * h); f32x4 a, b; unpack8f(w, a, b);
#pragma unroll
              for (int j = 0; j < 4; ++j) { Bs[ks + 8 * h + j][r] = a[j]; Bs[ks + 8 * h + 4 + j][r] = b[j]; } } }
        __syncthreads();
#pragma unroll 8
        for (int kk = 0; kk < 32; ++kk) {
            const f32x4 av = *(const f32x4*)&As[kk][4 * ty]; const f32x4 b0 = *(const f32x4*)&Bs[kk][8 * tx], b1 = *(const f32x4*)&Bs[kk][8 * tx + 4];
#pragma unroll
            for (int i = 0; i < 4; ++i) {
#pragma unroll
                for (int j = 0; j < 4; ++j) { acc[i][j] += av[i] * b0[j]; acc[i][4 + j] += av[i] * b1[j]; } }
        }
        __syncthreads();
    }
#pragma unroll
    for (int i = 0; i < 4; ++i) {
        const int row = m0 + 4 * ty + i, col = n0 + 8 * tx;
        f32x4 a = {acc[i][0], acc[i][1], acc[i][2], acc[i][3]}, b = {acc[i][4], acc[i][5], acc[i][6], acc[i][7]};
        if (WHICH == 0) epi_in8(P.ws, row, col >> 8, col & 255, a, b);
        if (WHICH == 1) epi_up1_8(P.ws, row, col, a, b);
        if (WHICH == 2) epi_up2_8(P.ws, row, col, a, b);
        if (WHICH == 3) {
            const f32x4 xa = *(const f32x4*)(P.x + (size_t)row * DM + col), xb = *(const f32x4*)(P.x + (size_t)row * DM + col + 4);
            a = a + xa; b = b + xb;
            *(f32x4*)(P.out + (size_t)row * DM + col) = a; *(f32x4*)(P.out + (size_t)row * DM + col + 4) = b;
            float s = (a[0] * a[0] + a[1] * a[1]) + (a[2] * a[2] + a[3] * a[3]) + (b[0] * b[0] + b[1] * b[1]) + (b[2] * b[2] + b[3] * b[3]);
            s += __shfl_xor(s, 1); s += __shfl_xor(s, 2); s += __shfl_xor(s, 4);
            if ((tx & 7) == 0) ((float*)(P.ws + WS_SS))[(size_t)row * 32 + blockIdx.x * 2 + (tx >> 3)] = s;
        }
    }
}
template <int KIND>
__global__ void __launch_bounds__(256) k_attn(Ptrs P) {
    __shared__ float q[256];
    __shared__ float sc[2][SEQ];
    __shared__ float red[8];
    unsigned char* ws = P.ws;
    const int tid = threadIdx.x, t = blockIdx.x, h = blockIdx.y, b = blockIdx.z;
    const size_t rowq = (size_t)(b * SEQ + t) * 2048;
    const bf16_t* Qb = KIND == 0 ? (const bf16_t*)(ws + WS_DQ) + h * 256 : (const bf16_t*)(ws + WS_RQK) + h * 128;
    const bf16_t* Kb = KIND == 0 ? (const bf16_t*)(ws + WS_DK) + h * 256 : (const bf16_t*)(ws + WS_RQK) + 1024 + h * 128;
    const bf16_t* Vb = (const bf16_t*)(ws + (KIND == 0 ? WS_DV : WS_RV)) + h * 256;
    constexpr int NC = KIND == 0 ? 2 : 1;
    if (tid < 128 * NC) q[tid] = __builtin_bit_cast(float, (unsigned)Qb[rowq + tid] << 16);
    __syncthreads();
    for (int s = tid; s <= t; s += 256) {
        const bf16_t* kr = Kb + (size_t)(b * SEQ + s) * 2048;
#pragma unroll
        for (int c = 0; c < NC; ++c) { float d = 0.f;
            for (int i = 0; i < 128; i += 8) { f32x4 ka, kb2; unpack8f(*(const u32x4*)(kr + c * 128 + i), ka, kb2);
                d += ka[0] * q[c * 128 + i] + ka[1] * q[c * 128 + i + 1] + ka[2] * q[c * 128 + i + 2] + ka[3] * q[c * 128 + i + 3]
                   + kb2[0] * q[c * 128 + i + 4] + kb2[1] * q[c * 128 + i + 5] + kb2[2] * q[c * 128 + i + 6] + kb2[3] * q[c * 128 + i + 7]; }
            sc[c][s] = KIND == 0 ? d * QK_SCALE : d; }
    }
    __syncthreads();
    float linv[2] = {1.f, 1.f};
    if (KIND == 0) {
#pragma unroll
        for (int c = 0; c < 2; ++c) {
            float mx = -3.0e38f; for (int s = tid; s <= t; s += 256) mx = fmaxf(mx, sc[c][s]);
#pragma unroll
            for (int o = 1; o < 64; o <<= 1) mx = fmaxf(mx, __shfl_xor(mx, o));
            if ((tid & 63) == 0) red[tid >> 6] = mx; __syncthreads();
            mx = fmaxf(fmaxf(red[0], red[1]), fmaxf(red[2], red[3])); __syncthreads();
            float sm = 0.f; for (int s = tid; s <= t; s += 256) { const float p = expf(sc[c][s] - mx); sc[c][s] = p; sm += p; }
            sm = wave_sum(sm);
            if ((tid & 63) == 0) red[4 + (tid >> 6)] = sm; __syncthreads();
            linv[c] = 1.0f / (red[4] + red[5] + red[6] + red[7]); __syncthreads();
        }
    }
    float o0 = 0.f, o1 = 0.f;
    for (int s = 0; s <= t; ++s) { const float v = __builtin_bit_cast(float, (unsigned)Vb[(size_t)(b * SEQ + s) * 2048 + tid] << 16); o0 += sc[0][s] * v; if (KIND == 0) o1 += sc[1][s] * v; }
    if (KIND == 0) { ((bf16_t*)(ws + WS_O1))[rowq + h * 256 + tid] = (bf16_t)f2bf(o0 * linv[0]); ((bf16_t*)(ws + WS_O2))[rowq + h * 256 + tid] = (bf16_t)f2bf(o1 * linv[1]); }
    else ((bf16_t*)(ws + WS_ORET))[rowq + h * 256 + tid] = (bf16_t)f2bf(o0);
}
static void launch_all(const Ptrs& P, hipStream_t stream) {
    unsigned char* ws = P.ws;
    k_prologue<<<512, 256, 0, stream>>>(P);
    k_gemm<0><<<dim3(NIN / 128, M / 64), 256, 0, stream>>>(P, (const bf16_t*)(ws + WS_XN), (const bf16_t*)(ws + WS_WINT), DM);
    k_attn<0><<<dim3(SEQ, 8, BATCH), 256, 0, stream>>>(P);
    k_attn<1><<<dim3(SEQ, 8, BATCH), 256, 0, stream>>>(P);
    k_post<<<256, 512, 0, stream>>>(P);
    k_gemm<1><<<dim3(DM / 128, M / 64), 256, 0, stream>>>(P, (const bf16_t*)(ws + WS_AR), (const bf16_t*)(ws + WS_WRUT), DM);
    k_gemm<2><<<dim3(DM / 128, M / 64), 256, 0, stream>>>(P, (const bf16_t*)(ws + WS_AD), (const bf16_t*)(ws + WS_WDUT), DM);
    k_gemm<3><<<dim3(DM / 128, M / 64), 256, 0, stream>>>(P, (const bf16_t*)(ws + WS_MIX), (const bf16_t*)(ws + WS_WOUTT), DM);
    k_final<<<256, 512, 0, stream>>>(P);
}
}
extern "C" void kernel_launch(void* const* d_in, const int* in_sizes, int n_in, void* d_out, int out_size, void* d_ws, size_t ws_size, hipStream_t stream) {
    static int ok = 0;
    if (ok == 0) {
        ok = 1;
        if (n_in != 12 || in_sizes[0] != M * DM || in_sizes[2] != DM * NIN || out_size != M * DM || ws_size < WS_END) {
            fprintf(stderr, "kernel_launch: unexpected shapes (n_in %d in0 %d in2 %d out %d ws %zu); nothing launched\n", n_in, n_in > 0 ? in_sizes[0] : -1, n_in > 2 ? in_sizes[2] : -1, out_size, ws_size); ok = -1; }
    }
    if (ok < 0) return;
    Ptrs P{};
    P.x = (const float*)d_in[0]; P.norm_w = (const float*)d_in[1]; P.w_in = (const float*)d_in[2]; P.w_ret_up = (const float*)d_in[3]; P.w_diff_up = (const float*)d_in[4];
    P.w_out = (const float*)d_in[5]; P.lq1 = (const float*)d_in[6]; P.lk1 = (const float*)d_in[7]; P.lq2 = (const float*)d_in[8]; P.lk2 = (const float*)d_in[9];
    P.subln_w = (const float*)d_in[10]; P.final_w = (const float*)d_in[11]; P.out = (float*)d_out; P.ws = (unsigned char*)d_ws;
#if MODE == 0
    naive::launch_all(P, stream);
#else
    opt_launch(P, stream);
#endif
}
```

```cpp
#include <hip/hip_runtime.h>
#include <hip/hip_cooperative_groups.h>
#include <hip/hip_bf16.h>
#include <cstdio>
#include <cstdint>
namespace cg = cooperative_groups;

#ifndef MODE
#define MODE 2
#endif

constexpr int BATCH = 4, SEQ = 2048, DM = 2048, M = BATCH * SEQ, NIN = 18432;
constexpr float NORM_EPS = 1e-6f, SUBLN_EPS = 1e-5f, LAM_INIT = 0.2f;
constexpr float QK_SCALE = 0.08838834764831845f;

constexpr size_t MiB = 1u << 20;
constexpr size_t WS_CTL = 0;
constexpr size_t WS_COSR = 1 * MiB, WS_SINR = WS_COSR + 512 * 1024, WS_COSD = 2 * MiB, WS_SIND = WS_COSD + 512 * 1024;
constexpr size_t WS_SS = 3 * MiB;
constexpr size_t WS_WRUT = 4 * MiB, WS_WDUT = 12 * MiB, WS_WOUTT = 20 * MiB;
constexpr size_t WS_WINT = 32 * MiB;
constexpr size_t WS_XN = 104 * MiB;
constexpr size_t WS_RQK = 136 * MiB;
constexpr size_t WS_RV = 168 * MiB, WS_SRZ = 200 * MiB, WS_DQ = 232 * MiB, WS_DK = 264 * MiB, WS_DV = 296 * MiB, WS_SDZ = 328 * MiB, WS_SGR = 360 * MiB, WS_SGD = 392 * MiB;
constexpr size_t WS_END = 424 * MiB;
constexpr size_t WS_ORET = 32 * MiB, WS_O1 = 64 * MiB, WS_O2 = 96 * MiB;
constexpr size_t WS_AR = 136 * MiB, WS_AD = 168 * MiB;
constexpr size_t WS_T = 232 * MiB;
constexpr size_t WS_MIX = 296 * MiB;

typedef unsigned short bf16_t;
typedef short bf16x8 __attribute__((ext_vector_type(8)));
typedef float f32x4 __attribute__((ext_vector_type(4)));
typedef float f32x2 __attribute__((ext_vector_type(2)));
typedef unsigned u32x4 __attribute__((ext_vector_type(4)));
typedef unsigned u32x2 __attribute__((ext_vector_type(2)));
#define LAS __attribute__((address_space(3)))

struct Ptrs {
    const float *x, *norm_w, *w_in, *w_ret_up, *w_diff_up, *w_out, *lq1, *lk1, *lq2, *lk2, *subln_w, *final_w;
    float* out; unsigned char* ws;
};

__device__ __forceinline__ unsigned f2bf(float f) { unsigned u = __builtin_bit_cast(unsigned, f); return (u + 0x7fffu + ((u >> 16) & 1u)) >> 16; }
__device__ __forceinline__ unsigned pk2(float lo, float hi) { return f2bf(lo) | (f2bf(hi) << 16); }
__device__ __forceinline__ float bflo(unsigned w) { return __builtin_bit_cast(float, w << 16); }
__device__ __forceinline__ float bfhi(unsigned w) { return __builtin_bit_cast(float, w & 0xffff0000u); }
__device__ __forceinline__ u32x4 pack8f(f32x4 a, f32x4 b) { u32x4 w; w.x = pk2(a[0], a[1]); w.y = pk2(a[2], a[3]); w.z = pk2(b[0], b[1]); w.w = pk2(b[2], b[3]); return w; }
__device__ __forceinline__ void unpack8f(u32x4 w, f32x4& a, f32x4& b) { a = (f32x4){bflo(w.x), bfhi(w.x), bflo(w.y), bfhi(w.y)}; b = (f32x4){bflo(w.z), bfhi(w.z), bflo(w.w), bfhi(w.w)}; }
__device__ __forceinline__ float sigmoidf_(float v) { return __builtin_amdgcn_rcpf(1.0f + __builtin_amdgcn_exp2f(-1.4426950408889634f * v)); }
__device__ __forceinline__ float wave_sum(float v) {
#pragma unroll
    for (int o = 1; o < 64; o <<= 1) v += __shfl_xor(v, o);
    return v;
}

__device__ __forceinline__ void epi_in8(unsigned char* ws, int row, int pn, int lcol, f32x4 a, f32x4 b) {
    const int t = row & (SEQ - 1);
    bf16_t* dst; int col;
    if (pn < 8 || (pn >= 24 && pn < 40)) {
        const bool ret = pn < 8;
        const int g = (lcol & 127) >> 3;
        const float* ct = (const float*)(ws + (ret ? WS_COSR : WS_COSD)) + t * 64 + 4 * g;
        const float* st = (const float*)(ws + (ret ? WS_SINR : WS_SIND)) + t * 64 + 4 * g;
        const f32x4 c = *(const f32x4*)ct, s = *(const f32x4*)st;
        f32x4 o1 = a * c - b * s, o2 = b * c + a * s;
        if (ret) {
            const int h = 2 * (pn & 3) + (lcol >> 7);
            const float l2g = ((const float*)(ws + WS_CTL))[16 + h];
            const float e = (float)(t - 1024) * l2g;
            const float sc = (pn >= 4) ? __builtin_amdgcn_exp2f(-e) * QK_SCALE : __builtin_amdgcn_exp2f(e);
            o1 = o1 * sc; o2 = o2 * sc;
            dst = (bf16_t*)(ws + WS_RQK); col = pn * 256 + lcol;
        } else if (pn < 32) { dst = (bf16_t*)(ws + WS_DQ); col = (pn - 24) * 256 + lcol; }
        else { dst = (bf16_t*)(ws + WS_DK); col = (pn - 32) * 256 + lcol; }
        *(u32x4*)(dst + (size_t)row * 2048 + col) = pack8f(o1, o2);
        return;
    }
    if (pn < 16) { dst = (bf16_t*)(ws + WS_RV); col = (pn - 8) * 256 + lcol; }
    else if (pn < 24) { dst = (bf16_t*)(ws + WS_SRZ); col = (pn - 16) * 256 + lcol;
#pragma unroll
        for (int i = 0; i < 4; ++i) { a[i] = a[i] * sigmoidf_(a[i]); b[i] = b[i] * sigmoidf_(b[i]); } }
    else if (pn < 48) { dst = (bf16_t*)(ws + WS_DV); col = (pn - 40) * 256 + lcol; }
    else if (pn < 56) { dst = (bf16_t*)(ws + WS_SDZ); col = (pn - 48) * 256 + lcol;
#pragma unroll
        for (int i = 0; i < 4; ++i) { a[i] = a[i] * sigmoidf_(a[i]); b[i] = b[i] * sigmoidf_(b[i]); } }
    else { dst = (bf16_t*)(ws + (pn < 64 ? WS_SGR : WS_SGD)); col = ((pn - 56) & 7) * 256 + lcol;
#pragma unroll
        for (int i = 0; i < 4; ++i) { a[i] = sigmoidf_(a[i]); b[i] = sigmoidf_(b[i]); } }
    *(u32x4*)(dst + (size_t)row * 2048 + col) = pack8f(a, b);
}
__device__ __forceinline__ void epi_up1_8(unsigned char* ws, int row, int col, f32x4 a, f32x4 b) {
    f32x4 ga, gb; unpack8f(*(const u32x4*)((const bf16_t*)(ws + WS_SGR) + (size_t)row * 2048 + col), ga, gb);
    float* T = (float*)(ws + WS_T) + (size_t)row * 2048 + col;
    *(f32x4*)T = a * ga; *(f32x4*)(T + 4) = b * gb;
}
__device__ __forceinline__ void epi_up2_8(unsigned char* ws, int row, int col, f32x4 a, f32x4 b) {
    f32x4 ga, gb; unpack8f(*(const u32x4*)((const bf16_t*)(ws + WS_SGD) + (size_t)row * 2048 + col), ga, gb);
    const float* T = (const float*)(ws + WS_T) + (size_t)row * 2048 + col;
    const f32x4 ta = *(const f32x4*)T, tb = *(const f32x4*)(T + 4);
    *(u32x4*)((bf16_t*)(ws + WS_MIX) + (size_t)row * 2048 + col) = pack8f(ta + a * ga, tb + b * gb);
}

__device__ __forceinline__ int win_dst_row(int c) {
    const bool qk = (c < 2048) || (c >= 6144 && c < 10240);
    const int d = c & 127, p = 8 * ((d & 63) >> 2) + 4 * (d >> 6) + (d & 3);
    return qk ? (c & ~127) + p : c;
}
template <bool PERMQK>
__device__ __forceinline__ void p0_transpose_item(const float* W, int K, int N, bf16_t* WT, LAS float* scr, int item, int lane) {
    const int nblk = N / 32, kb = item / nblk, nb = item % nblk, k0 = 64 * kb, n0 = 32 * nb;
#pragma unroll 8
    for (int i = 0; i < 32; ++i) { const int kk = 2 * i + (lane >> 5); scr[kk * 33 + (lane & 31)] = W[(size_t)(k0 + kk) * N + n0 + (lane & 31)]; }
    asm volatile("s_waitcnt lgkmcnt(0)" ::: "memory");
    const int c = lane & 7;
#pragma unroll
    for (int j = 0; j < 4; ++j) { const int n = (lane >> 3) + 8 * j; const LAS float* s = scr + (8 * c) * 33 + n;
        u32x4 o; o.x = pk2(s[0 * 33], s[1 * 33]); o.y = pk2(s[2 * 33], s[3 * 33]); o.z = pk2(s[4 * 33], s[5 * 33]); o.w = pk2(s[6 * 33], s[7 * 33]);
        const int drow = PERMQK ? win_dst_row(n0 + n) : (n0 + n);
        *(u32x4*)(WT + (size_t)drow * K + k0 + 8 * c) = o; }
    asm volatile("s_waitcnt lgkmcnt(0)" ::: "memory");
}
__device__ __forceinline__ void p0_prologue(const Ptrs& P, LAS float* scr, int gw, int NGW, int lane) {
    unsigned char* ws = P.ws;
    constexpr int I_IN = (DM / 64) * (NIN / 32), I_SQ = (DM / 64) * (DM / 32);
    for (int it = gw; it < I_IN + 3 * I_SQ; it += NGW) {
        int r = it;
        if (r < I_IN) { p0_transpose_item<true>(P.w_in, DM, NIN, (bf16_t*)(ws + WS_WINT), scr, r, lane); continue; } r -= I_IN;
        if (r < I_SQ) { p0_transpose_item<false>(P.w_ret_up, DM, DM, (bf16_t*)(ws + WS_WRUT), scr, r, lane); continue; } r -= I_SQ;
        if (r < I_SQ) { p0_transpose_item<false>(P.w_diff_up, DM, DM, (bf16_t*)(ws + WS_WDUT), scr, r, lane); continue; } r -= I_SQ;
        p0_transpose_item<false>(P.w_out, DM, DM, (bf16_t*)(ws + WS_WOUTT), scr, r, lane);
    }
    for (int m = gw; m < M; m += NGW) {
        const f32x4* xr = (const f32x4*)(P.x + (size_t)m * DM) + lane; const f32x4* wr_ = (const f32x4*)P.norm_w + lane;
        f32x4 v[8]; float s = 0.f;
#pragma unroll
        for (int j = 0; j < 8; ++j) { v[j] = xr[64 * j]; s += (v[j][0] * v[j][0] + v[j][1] * v[j][1]) + (v[j][2] * v[j][2] + v[j][3] * v[j][3]); }
        const float rstd = 1.0f / sqrtf(wave_sum(s) * (1.0f / DM) + NORM_EPS);
        u32x2* o8 = (u32x2*)((bf16_t*)(ws + WS_XN) + (size_t)m * DM) + lane;
#pragma unroll
        for (int j = 0; j < 8; ++j) { const f32x4 w = wr_[64 * j]; u32x2 o; o.x = pk2(v[j][0] * rstd * w[0], v[j][1] * rstd * w[1]); o.y = pk2(v[j][2] * rstd * w[2], v[j][3] * rstd * w[3]); o8[64 * j] = o; }
    }
    for (int i = gw * 64 + lane; i < SEQ * 64; i += NGW * 64) {
        const int t = i >> 6, f = i & 63;
#pragma unroll
        for (int which = 0; which < 2; ++which) {
            const double ex = which == 0 ? (double)f / 63.0 : (double)f / 64.0;
            const float inv = (float)exp(-9.210340371976184 * ex);
            const float ang = (float)t * inv;
            const double rev = (double)ang * 0.15915494309189535; const double fr = rev - floor(rev);
            const float a = (float)(fr * 6.283185307179586);
            ((float*)(ws + (which == 0 ? WS_COSR : WS_COSD)))[i] = cosf(a);
            ((float*)(ws + (which == 0 ? WS_SINR : WS_SIND)))[i] = sinf(a);
        }
    }
    if (gw == 0) {
        float* ctl = (float*)(ws + WS_CTL);
        const float s1 = wave_sum(P.lq1[lane] * P.lk1[lane] + P.lq1[lane + 64] * P.lk1[lane + 64]);
        const float s2 = wave_sum(P.lq2[lane] * P.lk2[lane] + P.lq2[lane + 64] * P.lk2[lane + 64]);
        if (lane == 0) ctl[0] = expf(s1) - expf(s2) + LAM_INIT;
        if (lane < 8) ctl[16 + lane] = (float)log2(1.0 - exp2(-5.0 - (double)lane));
    }
}
__device__ __forceinline__ void post_rows(const Ptrs& P, int gw, int NGW, int lane) {
    unsigned char* ws = P.ws;
    const float lam = ((const float*)(ws + WS_CTL))[0];
    const int cw = (lane & 7) * 32;
    for (int m = gw; m < M; m += NGW) {
        const size_t off = (size_t)m * 2048 + lane * 32;
        {
            f32x4 o[8]; float s = 0.f;
#pragma unroll
            for (int j = 0; j < 4; ++j) { unpack8f(*(const u32x4*)((const bf16_t*)(ws + WS_ORET) + off + 8 * j), o[2 * j], o[2 * j + 1]); }
#pragma unroll
            for (int j = 0; j < 8; ++j) s += (o[j][0] * o[j][0] + o[j][1] * o[j][1]) + (o[j][2] * o[j][2] + o[j][3] * o[j][3]);
            s += __shfl_xor(s, 1); s += __shfl_xor(s, 2); s += __shfl_xor(s, 4);
            const float rstd = 1.0f / sqrtf(s * (1.0f / 256.0f) + NORM_EPS);
#pragma unroll
            for (int j = 0; j < 4; ++j) { f32x4 za, zb; unpack8f(*(const u32x4*)((const bf16_t*)(ws + WS_SRZ) + off + 8 * j), za, zb);
                *(u32x4*)((bf16_t*)(ws + WS_AR) + off + 8 * j) = pack8f(o[2 * j] * rstd * za, o[2 * j + 1] * rstd * zb); }
        }
        {
            f32x4 d[8]; float s = 0.f;
#pragma unroll
            for (int j = 0; j < 4; ++j) { f32x4 a1, b1, a2, b2; unpack8f(*(const u32x4*)((const bf16_t*)(ws + WS_O1) + off + 8 * j), a1, b1); unpack8f(*(const u32x4*)((const bf16_t*)(ws + WS_O2) + off + 8 * j), a2, b2);
                d[2 * j] = a1 - a2 * lam; d[2 * j + 1] = b1 - b2 * lam; }
#pragma unroll
            for (int j = 0; j < 8; ++j) s += (d[j][0] * d[j][0] + d[j][1] * d[j][1]) + (d[j][2] * d[j][2] + d[j][3] * d[j][3]);
            s += __shfl_xor(s, 1); s += __shfl_xor(s, 2); s += __shfl_xor(s, 4);
            const float rstd = (1.0f - LAM_INIT) / sqrtf(s * (1.0f / 256.0f) + SUBLN_EPS);
#pragma unroll
            for (int j = 0; j < 4; ++j) { f32x4 za, zb; unpack8f(*(const u32x4*)((const bf16_t*)(ws + WS_SDZ) + off + 8 * j), za, zb);
                const f32x4 wa = *(const f32x4*)(P.subln_w + cw + 8 * j), wb = *(const f32x4*)(P.subln_w + cw + 8 * j + 4);
                *(u32x4*)((bf16_t*)(ws + WS_AD) + off + 8 * j) = pack8f(d[2 * j] * rstd * wa * za, d[2 * j + 1] * rstd * wb * zb); }
        }
    }
}
__device__ __forceinline__ void final_rows(const Ptrs& P, int gw, int NGW, int lane) {
    for (int m = gw; m < M; m += NGW) {
        const float part = ((const float*)(P.ws + WS_SS))[(size_t)m * 32 + (lane & 31)];
        const float tot = wave_sum(part) * 0.5f;
        const float rstd = 1.0f / sqrtf(tot * (1.0f / DM) + NORM_EPS);
        f32x4* hr = (f32x4*)(P.out + (size_t)m * DM) + lane; const f32x4* wr_ = (const f32x4*)P.final_w + lane;
#pragma unroll
        for (int j = 0; j < 8; ++j) { const f32x4 h = hr[64 * j]; hr[64 * j] = h * rstd * wr_[64 * j]; }
    }
}
namespace naive {
__global__ void __launch_bounds__(256) k_prologue(Ptrs P) {
    __shared__ float scr_all[4 * 64 * 33];
    const int lane = threadIdx.x & 63, wave = threadIdx.x >> 6;
    p0_prologue(P, (LAS float*)(scr_all + wave * 64 * 33), blockIdx.x * 4 + wave, gridDim.x * 4, lane);
}
__global__ void __launch_bounds__(512) k_post(Ptrs P) { post_rows(P, blockIdx.x * 8 + (threadIdx.x >> 6), gridDim.x * 8, threadIdx.x & 63); }
__global__ void __launch_bounds__(512) k_final(Ptrs P) { final_rows(P, blockIdx.x * 8 + (threadIdx.x >> 6), gridDim.x * 8, threadIdx.x & 63); }

template <int WHICH>
__global__ void __launch_bounds__(256) k_gemm(Ptrs P, const bf16_t* A, const bf16_t* Bt, int K) {
    __shared__ float As[32][68];
    __shared__ float Bs[32][132];
    const int tid = threadIdx.x, ty = tid >> 4, tx = tid & 15;
    const int m0 = blockIdx.y * 64, n0 = blockIdx.x * 128;
    float acc[4][8];
#pragma unroll
    for (int i = 0; i < 4; ++i)
#pragma unroll
        for (int j = 0; j < 8; ++j) acc[i][j] = 0.f;
    for (int k0 = 0; k0 < K; k0 += 32) {
        { const int r = tid >> 2, ks = (tid & 3) * 8; const u32x4 w = *(const u32x4*)(A + (size_t)(m0 + r) * K + k0 + ks); f32x4 a, b; unpack8f(w, a, b);
#pragma unroll
          for (int j = 0; j < 4; ++j) { As[ks + j][r] = a[j]; As[ks + 4 + j][r] = b[j]; } }
        { const int r = tid >> 1, ks = (tid & 1) * 16;
#pragma unroll
          for (int h = 0; h < 2; ++h) { const u32x4 w = *(const u32x4*)(Bt + (size_t)(n0 + r) * K + k0 + ks + 8 * h); f32x4 a, b; unpack8f(w, a, b);
#pragma unroll
              for (int j = 0; j < 4; ++j) { Bs[ks + 8 * h + j][r] = a[j]; Bs[ks + 8 * h + 4 + j][r] = b[j]; } } }
        __syncthreads();
#pragma unroll 8
        for (int kk = 0; kk < 32; ++kk) {
            const f32x4 av = *(const f32x4*)&As[kk][4 * ty]; const f32x4 b0 = *(const f32x4*)&Bs[kk][8 * tx], b1 = *(const f32x4*)&Bs[kk][8 * tx + 4];
#pragma unroll
            for (int i = 0; i < 4; ++i) {
#pragma unroll
                for (int j = 0; j < 4; ++j) { acc[i][j] += av[i] * b0[j]; acc[i][4 + j] += av[i] * b1[j]; } }
        }
        __syncthreads();
    }
#pragma unroll
    for (int i = 0; i < 4; ++i) {
        const int row = m0 + 4 * ty + i, col = n0 + 8 * tx;
        f32x4 a = {acc[i][0], acc[i][1], acc[i][2], acc[i][3]}, b = {acc[i][4], acc[i][5], acc[i][6], acc[i][7]};
        if (WHICH == 0) epi_in8(P.ws, row, col >> 8, col & 255, a, b);
        if (WHICH == 1) epi_up1_8(P.ws, row, col, a, b);
        if (WHICH == 2) epi_up2_8(P.ws, row, col, a, b);
        if (WHICH == 3) {
            const f32x4 xa = *(const f32x4*)(P.x + (size_t)row * DM + col), xb = *(const f32x4*)(P.x + (size_t)row * DM + col + 4);
            a = a + xa; b = b + xb;
            *(f32x4*)(P.out + (size_t)row * DM + col) = a; *(f32x4*)(P.out + (size_t)row * DM + col + 4) = b;
            float s = (a[0] * a[0] + a[1] * a[1]) + (a[2] * a[2] + a[3] * a[3]) + (b[0] * b[0] + b[1] * b[1]) + (b[2] * b[2] + b[3] * b[3]);
            s += __shfl_xor(s, 1); s += __shfl_xor(s, 2); s += __shfl_xor(s, 4);
            if ((tx & 7) == 0) ((float*)(P.ws + WS_SS))[(size_t)row * 32 + blockIdx.x * 2 + (tx >> 3)] = s;
        }
    }
}
template <int KIND>
__global__ void __launch_bounds__(256) k_attn(Ptrs P) {
    __shared__ float q[256];
    __shared__ float sc[2][SEQ];
    __shared__ float red[8];
    unsigned char* ws = P.ws;
    const int tid = threadIdx.x, t = blockIdx.x, h = blockIdx.y, b = blockIdx.z;
    const size_t rowq = (size_t)(b * SEQ + t) * 2048;
    const bf16_t* Qb = KIND == 0 ? (const bf16_t*)(ws + WS_DQ) + h * 256 : (const bf16_t*)(ws + WS_RQK) + h * 128;
    const bf16_t* Kb = KIND == 0 ? (const bf16_t*)(ws + WS_DK) + h * 256 : (const bf16_t*)(ws + WS_RQK) + 1024 + h * 128;
    const bf16_t* Vb = (const bf16_t*)(ws + (KIND == 0 ? WS_DV : WS_RV)) + h * 256;
    constexpr int NC = KIND == 0 ? 2 : 1;
    if (tid < 128 * NC) q[tid] = __builtin_bit_cast(float, (unsigned)Qb[rowq + tid] << 16);
    __syncthreads();
    for (int s = tid; s <= t; s += 256) {
        const bf16_t* kr = Kb + (size_t)(b * SEQ + s) * 2048;
#pragma unroll
        for (int c = 0; c < NC; ++c) { float d = 0.f;
            for (int i = 0; i < 128; i += 8) { f32x4 ka, kb2; unpack8f(*(const u32x4*)(kr + c * 128 + i), ka, kb2);
                d += ka[0] * q[c * 128 + i] + ka[1] * q[c * 128 + i + 1] + ka[2] * q[c * 128 + i + 2] + ka[3] * q[c * 128 + i + 3]
                   + kb2[0] * q[c * 128 + i + 4] + kb2[1] * q[c * 128 + i + 5] + kb2[2] * q[c * 128 + i + 6] + kb2[3] * q[c * 128 + i + 7]; }
            sc[c][s] = KIND == 0 ? d * QK_SCALE : d; }
    }
    __syncthreads();
    float linv[2] = {1.f, 1.f};
    if (KIND == 0) {
#pragma unroll
        for (int c = 0; c < 2; ++c) {
            float mx = -3.0e38f; for (int s = tid; s <= t; s += 256) mx = fmaxf(mx, sc[c][s]);
#pragma unroll
            for (int o = 1; o < 64; o <<= 1) mx = fmaxf(mx, __shfl_xor(mx, o));
            if ((tid & 63) == 0) red[tid >> 6] = mx; __syncthreads();
            mx = fmaxf(fmaxf(red[0], red[1]), fmaxf(red[2], red[3])); __syncthreads();
            float sm = 0.f; for (int s = tid; s <= t; s += 256) { const float p = expf(sc[c][s] - mx); sc[c][s] = p; sm += p; }
            sm = wave_sum(sm);
            if ((tid & 63) == 0) red[4 + (tid >> 6)] = sm; __syncthreads();
            linv[c] = 1.0f / (red[4] + red[5] + red[6] + red[7]); __syncthreads();
        }
    }
    float o0 = 0.f, o1 = 0.f;
    for (int s = 0; s <= t; ++s) { const float v = __builtin_bit_cast(float, (unsigned)Vb[(size_t)(b * SEQ + s) * 2048 + tid] << 16); o0 += sc[0][s] * v; if (KIND == 0) o1 += sc[1][s] * v; }
    if (KIND == 0) { ((bf16_t*)(ws + WS_O1))[rowq + h * 256 + tid] = (bf16_t)f2bf(o0 * linv[0]); ((bf16_t*)(ws + WS_O2))[rowq + h * 256 + tid] = (bf16_t)f2bf(o1 * linv[1]); }
    else ((bf16_t*)(ws + WS_ORET))[rowq + h * 256 + tid] = (bf16_t)f2bf(o0);
}
static void launch_all(const Ptrs& P, hipStream_t stream) {
    unsigned char* ws = P.ws;
    k_prologue<<<512, 256, 0, stream>>>(P);
    k_gemm<0><<<dim3(NIN / 128, M / 64), 256, 0, stream>>>(P, (const bf16_t*)(ws + WS_XN), (const bf16_t*)(ws + WS_WINT), DM);
    k_attn<0><<<dim3(SEQ, 8, BATCH), 256, 0, stream>>>(P);
    k_attn<1><<<dim3(SEQ, 8, BATCH), 256, 0, stream>>>(P);
    k_post<<<256, 512, 0, stream>>>(P);
    k_gemm<1><<<dim3(DM / 128, M / 64), 256, 0, stream>>>(P, (const bf16_t*)(ws + WS_AR), (const bf16_t*)(ws + WS_WRUT), DM);
    k_gemm<2><<<dim3(DM / 128, M / 64), 256, 0, stream>>>(P, (const bf16_t*)(ws + WS_AD), (const bf16_t*)(ws + WS_WDUT), DM);
    k_gemm<3><<<dim3(DM / 128, M / 64), 256, 0, stream>>>(P, (const bf16_t*)(ws + WS_MIX), (const bf16_t*)(ws + WS_WOUTT), DM);
    k_final<<<256, 512, 0, stream>>>(P);
}
}
#if MODE != 0
namespace pg8 {
#define PG8_LAS __attribute__((address_space(3)))
typedef unsigned short bf16_t;
typedef short bf16x8 __attribute__((ext_vector_type(8)));
typedef float f32x4 __attribute__((ext_vector_type(4)));
typedef unsigned u32x4 __attribute__((ext_vector_type(4)));
constexpr int BM = 256, BK = 64, HALF = 128, HTB = HALF * BK * 2  , STAGE_BYTES = 8 * HTB, NXCD = 8, WGM = 8;

__host__ __device__ __forceinline__ int lds_byte(int r, int c) { const int st = (r >> 4) * 2 + (c >> 5), rr = r & 15, cc = c & 31, ob = rr * 64 + cc * 2; return st * 1024 + (ob ^ (((ob >> 9) & 1) << 5)); }
__host__ __device__ __forceinline__ void stage_rc(int b, int& R, int& C) { const int st = b / 1024, sb = b % 1024, swz = sb ^ (((sb >> 9) & 1) << 5); R = (st >> 1) * 16 + swz / 64; C = (st & 1) * 32 + (swz % 64) / 2; }
__host__ __device__ __forceinline__ int perm32(int rho) { const int n = rho >> 4, i = rho & 15; return 8 * (i >> 2) + 4 * n + (i & 3); }

struct Unit { int pm, pn; };
struct Gemm { const bf16_t* A; const bf16_t* Bt; int M, N, K; };

struct StaticOrder {
    int nM, nN, nwg, G, c;
    __host__ __device__ void init(int M, int N, int G_, int c_) { nM = M / BM; nN = N / BM; nwg = nM * nN; G = G_; c = c_; }
    __host__ __device__ bool next(int i, Unit& u) const {
        const long L = (long)i * G + c; if (L >= nwg) return false;
        int wgid = (int)L; { const int q = nwg / NXCD, r = nwg % NXCD, xcd = wgid % NXCD, off = wgid / NXCD; wgid = (xcd < r ? xcd * (q + 1) : r * (q + 1) + (xcd - r) * q) + off; }
        const int nig = WGM * nN, gid = wgid / nig, fm = gid * WGM, gsz = (nM - fm) < WGM ? (nM - fm) : WGM;
        u.pm = fm + ((wgid % nig) % gsz); u.pn = (wgid % nig) / gsz; return true;
    }
    __device__ __forceinline__ void a_ready(const Unit&) const {}
    __device__ __forceinline__ void done(const Unit&) const {}
};

struct EpiIn {
    static constexpr bool PERM = true, AFTER_DRAIN = false; unsigned char* ws;
    __device__ __forceinline__ void operator()(const f32x4 (&acc)[2][2][4][2], const Unit& u, int wr, int wc, int fr, int fq) const {
        const int row0 = u.pm * BM + wr * 64 + fr, lcol0 = wc * 32 + 8 * fq;
#pragma unroll
        for (int ai = 0; ai < 2; ++ai)
#pragma unroll
            for (int m = 0; m < 4; ++m)
#pragma unroll
                for (int bj = 0; bj < 2; ++bj) epi_in8(ws, row0 + ai * HALF + m * 16, u.pn, bj * HALF + lcol0, acc[ai][bj][m][0], acc[ai][bj][m][1]);
    }
};
template <int WHICH> struct EpiUp {
    static constexpr bool PERM = true, AFTER_DRAIN = false; unsigned char* ws;
    __device__ __forceinline__ void operator()(const f32x4 (&acc)[2][2][4][2], const Unit& u, int wr, int wc, int fr, int fq) const {
        const int row0 = u.pm * BM + wr * 64 + fr, col0 = u.pn * BM + wc * 32 + 8 * fq;
#pragma unroll
        for (int ai = 0; ai < 2; ++ai)
#pragma unroll
            for (int m = 0; m < 4; ++m)
#pragma unroll
                for (int bj = 0; bj < 2; ++bj) {
                    if (WHICH == 1) epi_up1_8(ws, row0 + ai * HALF + m * 16, col0 + bj * HALF, acc[ai][bj][m][0], acc[ai][bj][m][1]);
                    else epi_up2_8(ws, row0 + ai * HALF + m * 16, col0 + bj * HALF, acc[ai][bj][m][0], acc[ai][bj][m][1]); }
    }
};
struct EpiOut {
    static constexpr bool PERM = false, AFTER_DRAIN = false; const float* x; float* out; float* ss;
    __device__ __forceinline__ void operator()(const f32x4 (&acc)[2][2][4][2], const Unit& u, int wr, int wc, int fr, int fq) const {
        const int row0 = u.pm * BM + wr * 64 + fr, col0 = u.pn * BM + wc * 32 + 4 * fq;
#pragma unroll
        for (int ai = 0; ai < 2; ++ai)
#pragma unroll
            for (int m = 0; m < 4; ++m) { const int row = row0 + ai * HALF + m * 16; const size_t off = (size_t)row * DM + col0; float s = 0.f;
#pragma unroll
                for (int bj = 0; bj < 2; ++bj)
#pragma unroll
                    for (int n = 0; n < 2; ++n) { const f32x4 h = *(const f32x4*)(x + off + bj * HALF + n * 16) + acc[ai][bj][m][n];
                        *(f32x4*)(out + off + bj * HALF + n * 16) = h; s += (h[0] * h[0] + h[1] * h[1]) + (h[2] * h[2] + h[3] * h[3]); }
                s += __shfl_xor(s, 16); s += __shfl_xor(s, 32);
                if (fq == 0) ss[(size_t)row * 32 + u.pn * 4 + wc] = s; }
    }
};
template <class Epi, class Sched, bool ALIGN_EPI = false, bool SP2 = false>
__device__ __forceinline__ void gemm_phase(PG8_LAS unsigned char* lds, const Gemm g, const Sched& S, const Epi& E) {
    const int tid = threadIdx.x, wid = __builtin_amdgcn_readfirstlane(tid >> 6), lane = tid & 63, wr = wid >> 2, wc = wid & 3, fr = lane & 15, fq = lane >> 4;
    const int K = g.K, nt = K / BK;
    unsigned voffA[2], voffB[2];
#pragma unroll
    for (int i = 0; i < 2; ++i) { int R, C; stage_rc(tid * 16 + i * 8192, R, C); const int Rb = Epi::PERM ? ((R & ~31) + perm32(R & 31)) : R;
        voffA[i] = (unsigned)(R * K + C) * 2u; voffB[i] = (unsigned)(Rb * K + C) * 2u; }
    const size_t kstep = (size_t)(BK * 2);
    const size_t hstep = (size_t)HALF * K * 2;
    const size_t tstep = 2 * hstep;
    const unsigned ldsw = (unsigned)wid * 1024u;
    const int aoff = lds_byte(wr * 64 + fr, fq * 8), boff = lds_byte(wc * 32 + fr, fq * 8);
#define PG8_SA(b, h) (((b) * 2 + (h)) * HTB)
#define PG8_SB(b, h) ((4 + (b) * 2 + (h)) * HTB)
#define PG8_STAGE(bufoff, gbase, voff) do { _Pragma("unroll") for (int _i = 0; _i < 2; ++_i) \
        __builtin_amdgcn_global_load_lds((const unsigned*)((const char*)(gbase) + (voff)[_i]), (PG8_LAS unsigned*)(lds + (bufoff) + ldsw + _i * 8192), 16, 0, 0); } while (0)
#define PG8_LDA(dst, b, h) do { _Pragma("unroll") for (int m = 0; m < 4; ++m) _Pragma("unroll") for (int k = 0; k < 2; ++k) dst[m][k] = *(const PG8_LAS bf16x8*)(lds + PG8_SA(b, h) + aoff + m * 2048 + k * 1024); } while (0)
#define PG8_LDB(dst, b, h) do { _Pragma("unroll") for (int n = 0; n < 2; ++n) _Pragma("unroll") for (int k = 0; k < 2; ++k) dst[n][k] = *(const PG8_LAS bf16x8*)(lds + PG8_SB(b, h) + boff + n * 2048 + k * 1024); } while (0)
#define PG8_MMA(ai, bj, At, Bt) do { __builtin_amdgcn_s_setprio(1); _Pragma("unroll") for (int m = 0; m < 4; ++m) _Pragma("unroll") for (int n = 0; n < 2; ++n) _Pragma("unroll") for (int k = 0; k < 2; ++k) \
        acc[ai][bj][m][n] = __builtin_amdgcn_mfma_f32_16x16x32_bf16(Bt[n][k], At[m][k], acc[ai][bj][m][n], 0, 0, 0); __builtin_amdgcn_s_setprio(0); } while (0)
#define PG8_WAIT_V(n) asm volatile("s_waitcnt vmcnt(" #n ")" ::: "memory")
#define PG8_WAIT_L(n) asm volatile("s_waitcnt lgkmcnt(" #n ")" ::: "memory")
#define PG8_BAR __builtin_amdgcn_s_barrier()
#define PG8_SCHED __builtin_amdgcn_sched_barrier(0)
    Unit cur, nxt; int ui = 0;
    if (!S.next(0, cur)) return;
    f32x4 acc[2][2][4][2];
#pragma unroll
    for (int a = 0; a < 2; ++a)
#pragma unroll
        for (int b = 0; b < 2; ++b)
#pragma unroll
            for (int m = 0; m < 4; ++m)
#pragma unroll
                for (int n = 0; n < 2; ++n) acc[a][b][m][n] = (f32x4){0.f, 0.f, 0.f, 0.f};
    bf16x8 At[4][2], B0[2][2], B1[2][2];
    const char* cA = (const char*)g.A + (size_t)cur.pm * tstep; const char* cB = (const char*)g.Bt + (size_t)cur.pn * tstep;
    S.a_ready(cur);
    if constexpr (SP2) {
        PG8_STAGE(PG8_SB(0, 0), cB, voffB); PG8_STAGE(PG8_SB(0, 1), cB + hstep, voffB); PG8_STAGE(PG8_SA(0, 0), cA, voffA); PG8_STAGE(PG8_SA(0, 1), cA + hstep, voffA);
        if (wr == 1) PG8_BAR;
        PG8_WAIT_V(2); PG8_BAR;
        PG8_STAGE(PG8_SB(1, 0), cB + kstep, voffB); PG8_STAGE(PG8_SA(1, 0), cA + kstep, voffA); PG8_STAGE(PG8_SB(1, 1), cB + hstep + kstep, voffB);
        PG8_WAIT_V(6); PG8_BAR;
    } else {
        PG8_STAGE(PG8_SB(0, 0), cB, voffB); PG8_STAGE(PG8_SA(0, 0), cA, voffA); PG8_STAGE(PG8_SB(0, 1), cB + hstep, voffB); PG8_STAGE(PG8_SA(0, 1), cA + hstep, voffA);
        if (wr == 1) PG8_BAR;
        PG8_WAIT_V(4); PG8_BAR;
        PG8_STAGE(PG8_SB(1, 0), cB + kstep, voffB); PG8_STAGE(PG8_SA(1, 0), cA + kstep, voffA); PG8_STAGE(PG8_SB(1, 1), cB + hstep + kstep, voffB);
        PG8_WAIT_V(6); PG8_BAR;
    }
    for (;;) {
        const bool has_next = S.next(ui + 1, nxt);
        const char* nA = has_next ? (const char*)g.A + (size_t)nxt.pm * tstep : cA; const char* nB = has_next ? (const char*)g.Bt + (size_t)nxt.pn * tstep : cB;
        for (int t = 0; t < nt; t += 2) {
            const bool last = (t == nt - 2);
            const char* a1 = cA + (size_t)(t + 1) * kstep;
            const char* a2 = last ? nA : cA + (size_t)(t + 2) * kstep; const char* b2 = last ? nB : cB + (size_t)(t + 2) * kstep;
            const char* a3 = a2 + kstep; const char* b3 = b2 + kstep;
            if (last && has_next) S.a_ready(nxt);
            if constexpr (SP2) {
            PG8_LDB(B0, 0, 0); PG8_LDB(B1, 0, 1); PG8_SCHED; PG8_LDA(At, 0, 0); PG8_STAGE(PG8_SA(1, 1), a1 + hstep, voffA);
            PG8_WAIT_V(8); PG8_WAIT_L(0); PG8_BAR; PG8_MMA(0, 0, At, B0); PG8_MMA(0, 1, At, B1); PG8_BAR; PG8_SCHED;
            PG8_LDA(At, 0, 1); PG8_STAGE(PG8_SB(0, 0), b2, voffB); PG8_STAGE(PG8_SB(0, 1), b2 + hstep, voffB); PG8_STAGE(PG8_SA(0, 0), a2, voffA);
            PG8_WAIT_V(8); PG8_WAIT_L(0); PG8_BAR; PG8_MMA(1, 0, At, B0); PG8_MMA(1, 1, At, B1); PG8_BAR; PG8_SCHED;
            PG8_LDB(B0, 1, 0); PG8_LDB(B1, 1, 1); PG8_SCHED; PG8_LDA(At, 1, 0); PG8_STAGE(PG8_SA(0, 1), a2 + hstep, voffA);
            PG8_WAIT_V(8); PG8_WAIT_L(0); PG8_BAR; PG8_MMA(0, 0, At, B0); PG8_MMA(0, 1, At, B1); PG8_BAR; PG8_SCHED;
            PG8_LDA(At, 1, 1); PG8_STAGE(PG8_SB(1, 0), b3, voffB); PG8_STAGE(PG8_SB(1, 1), b3 + hstep, voffB); PG8_STAGE(PG8_SA(1, 0), a3, voffA);
            PG8_WAIT_V(8); PG8_WAIT_L(0); PG8_BAR; PG8_MMA(1, 0, At, B0); PG8_MMA(1, 1, At, B1); PG8_BAR; PG8_SCHED;
            } else {
            PG8_LDB(B0, 0, 0); PG8_SCHED; PG8_LDA(At, 0, 0); PG8_STAGE(PG8_SA(1, 1), a1 + hstep, voffA);
            PG8_WAIT_L(8); PG8_BAR; PG8_WAIT_L(0); PG8_MMA(0, 0, At, B0); PG8_BAR; PG8_SCHED;
            PG8_LDB(B1, 0, 1); PG8_STAGE(PG8_SB(0, 0), b2, voffB);
            PG8_BAR; PG8_WAIT_L(0); PG8_MMA(0, 1, At, B1); PG8_BAR;
            PG8_LDA(At, 0, 1); PG8_STAGE(PG8_SA(0, 0), a2, voffA);
            PG8_BAR; PG8_WAIT_L(0); PG8_MMA(1, 0, At, B0); PG8_BAR; PG8_SCHED;
            PG8_STAGE(PG8_SB(0, 1), b2 + hstep, voffB);
            PG8_WAIT_V(6); PG8_BAR; PG8_MMA(1, 1, At, B1); PG8_BAR;
            PG8_LDB(B0, 1, 0); PG8_SCHED; PG8_LDA(At, 1, 0); PG8_STAGE(PG8_SA(0, 1), a2 + hstep, voffA);
            PG8_WAIT_L(8); PG8_BAR; PG8_WAIT_L(0); PG8_MMA(0, 0, At, B0); PG8_BAR; PG8_SCHED;
            PG8_LDB(B1, 1, 1); PG8_STAGE(PG8_SB(1, 0), b3, voffB);
            PG8_BAR; PG8_WAIT_L(0); PG8_MMA(0, 1, At, B1); PG8_BAR;
            PG8_LDA(At, 1, 1); PG8_STAGE(PG8_SA(1, 0), a3, voffA);
            PG8_BAR; PG8_WAIT_L(0); PG8_MMA(1, 0, At, B0); PG8_BAR; PG8_SCHED;
            PG8_STAGE(PG8_SB(1, 1), b3 + hstep, voffB);
            PG8_WAIT_V(6); PG8_BAR; PG8_MMA(1, 1, At, B1); PG8_BAR;
            }
        }
        if constexpr (ALIGN_EPI) { if (wr == 0) PG8_BAR; }
        if constexpr (!Epi::AFTER_DRAIN) { E(acc, cur, wr, wc, fr, fq); S.done(cur); }
        if (!has_next) break;
#pragma unroll
        for (int a = 0; a < 2; ++a)
#pragma unroll
            for (int b = 0; b < 2; ++b)
#pragma unroll
                for (int m = 0; m < 4; ++m)
#pragma unroll
                    for (int n = 0; n < 2; ++n) acc[a][b][m][n] = (f32x4){0.f, 0.f, 0.f, 0.f};
        cur = nxt; cA = nA; cB = nB; ++ui;
        if constexpr (ALIGN_EPI) { if (wr == 1) PG8_BAR; }
    }
    PG8_WAIT_V(0);
    if constexpr (!ALIGN_EPI) { if (wr == 0) PG8_BAR; }
    PG8_BAR;
    if constexpr (Epi::AFTER_DRAIN) { E.fused(acc, cur, wr, wc, fr, fq, lds, wid, lane); S.done(cur); }
#undef PG8_SA
#undef PG8_SB
#undef PG8_STAGE
#undef PG8_LDA
#undef PG8_LDB
#undef PG8_MMA
#undef PG8_WAIT_V
#undef PG8_WAIT_L
#undef PG8_BAR
#undef PG8_SCHED
}
}

namespace att {
constexpr int D = 128, LD = 2048;
constexpr float THR = 8.f; constexpr bool WSKIP = false;
constexpr float SCALE = 0.08838834764831845f;
constexpr int NW = 8, QBLK = 32, KVBLK = 64, QB = NW * QBLK;
constexpr int SHM_V = KVBLK * D * 2, SHM_K = KVBLK * D * 2;
constexpr int ATT_LDS_BYTES = 2 * SHM_V + 2 * SHM_K + NW * 64 * 4;
using bf16 = __hip_bfloat16;
typedef short s16x4 __attribute__((ext_vector_type(4)));
typedef float f32x16 __attribute__((ext_vector_type(16)));
template <class A, class Bt> struct same_t { static constexpr bool v = false; };
template <class A> struct same_t<A, A> { static constexpr bool v = true; };

#define KSWZ(row, colB) ((row) * 256 + ((colB) ^ (((row) & 7) << 4)))
#define SBAR() __builtin_amdgcn_sched_barrier(0)
__device__ __forceinline__ int v_st(int k, int c) { const int kk = (k & ~0xC) | ((k & 4) << 1) | ((k & 8) >> 1); return ((kk >> 3) * 4 + (c >> 5)) * 512 + ((kk & 7) * 32 + (c & 31)) * 2; }
__device__ __forceinline__ int v_rd_base(int lane) { return ((lane & 3) << 3) | (((lane >> 2) & 3) << 6) | (((lane >> 4) & 1) << 5) | (((lane >> 5) & 1) << 8); }
constexpr int v_rd_off(int d0, int ks, int half) { return d0 * 512 + ks * 4096 + half * 2048; }
__device__ __forceinline__ int crow(int r, int hi) { return (r & 3) + 8 * (r >> 2) + 4 * hi; }
__device__ __forceinline__ unsigned cvtpk(float lo, float hi) {
    unsigned r; asm volatile("v_cvt_pk_bf16_f32 %0, %1, %2" : "=v"(r) : "v"(lo), "v"(hi)); return r;
}
__device__ __forceinline__ bf16x8 pack8(f32x4 a, f32x4 b) {
    u32x4 w = {cvtpk(a[0], a[1]), cvtpk(a[2], a[3]), cvtpk(b[0], b[1]), cvtpk(b[2], b[3])};
    return *reinterpret_cast<bf16x8*>(&w);
}
template <class T> __device__ __forceinline__ bf16x8 load8(const T* p) {
    if constexpr (same_t<T, float>::v) { return pack8(*(const f32x4*)p, *(const f32x4*)(p + 4)); }
    else { return *reinterpret_cast<const bf16x8*>(p); }
}
template <bool LIN> __device__ __forceinline__ void mask_tile(f32x16& p0, f32x16& p1, int dq, unsigned W) {
    const float NEG = LIN ? 0.f : -__builtin_inff();
#pragma unroll
    for (int r = 0; r < 16; ++r) {
        const int c = (r & 3) + 8 * (r >> 2);
        if ((unsigned)(dq - c) >= W) p0[r] = NEG;
        if ((unsigned)(dq - c - 32) >= W) p1[r] = NEG;
    }
}
template <bool LIN> __device__ __forceinline__ void partialSM(f32x16& p0, f32x16& p1, float& m_reg, float& mn, float& alpha) {
    if constexpr (LIN) { alpha = 1.f; mn = 0.f; return; }
    float pmax = p0[0]; for (int r = 1; r < 16; ++r) pmax = fmaxf(pmax, p0[r]); for (int r = 0; r < 16; ++r) pmax = fmaxf(pmax, p1[r]);
    { auto rr = __builtin_amdgcn_permlane32_swap(__float_as_uint(pmax), __float_as_uint(pmax), false, false);
      pmax = fmaxf(__uint_as_float(rr[0]), __uint_as_float(rr[1])); }
    constexpr float C2 = 1.4426950408889634f * SCALE;
    if (__builtin_expect(__all((pmax - m_reg) * SCALE <= THR), 1)) { mn = m_reg; alpha = 1.f; }
    else { mn = fmaxf(m_reg, pmax); alpha = __builtin_amdgcn_exp2f((m_reg - mn) * C2); m_reg = mn; }
    const float mnL = -mn * C2;
    for (int r = 0; r < 16; ++r) p0[r] = fmaf(p0[r], C2, mnL); for (int r = 0; r < 16; ++r) p1[r] = fmaf(p1[r], C2, mnL);
    for (int r = 0; r < 16; ++r) p0[r] = __builtin_amdgcn_exp2f(p0[r]);
}
template <bool LIN> __device__ __forceinline__ void finishSM(f32x16& p0, f32x16& p1, float alpha, float& l_reg, bf16x8& pa0, bf16x8& pa1, bf16x8& pa2, bf16x8& pa3) {
    if constexpr (!LIN) {
    for (int r = 0; r < 16; ++r) p1[r] = __builtin_amdgcn_exp2f(p1[r]);
    float ps = 0; for (int r = 0; r < 16; ++r) ps += p0[r]; for (int r = 0; r < 16; ++r) ps += p1[r];
    { auto rr = __builtin_amdgcn_permlane32_swap(__float_as_uint(ps), __float_as_uint(ps), false, false);
      ps = __uint_as_float(rr[0]) + __uint_as_float(rr[1]); }
    l_reg = l_reg * alpha + ps;
    }
#define PK4(P, B_, OUT) do { unsigned a0 = cvtpk(P[B_+0], P[B_+1]), a1 = cvtpk(P[B_+2], P[B_+3]);                          \
        unsigned b0 = cvtpk(P[B_+4], P[B_+5]), b1 = cvtpk(P[B_+6], P[B_+7]);                                             \
        auto r0 = __builtin_amdgcn_permlane32_swap(a0, b0, false, false); auto r1 = __builtin_amdgcn_permlane32_swap(a1, b1, false, false); \
        u32x4 w = {r0[0], r1[0], r0[1], r1[1]}; OUT = *reinterpret_cast<bf16x8*>(&w); } while (0)
    PK4(p0, 0, pa0); PK4(p0, 8, pa1); PK4(p1, 0, pa2); PK4(p1, 8, pa3);
#undef PK4
}
template <int KB, bool SK>
__device__ __forceinline__ void qkt(f32x16& p0, f32x16& p1, const char* K_lds, int r32, int hi, const bf16x8* qr, bool act) {
    if (SK && !act) { const float NEG = -__builtin_inff();
#pragma unroll
        for (int r = 0; r < 16; ++r) { p0[r] = NEG; p1[r] = NEG; } return; }
    p0 = f32x16{}; p1 = f32x16{};
    const char* kb[4];
#pragma unroll
    for (int dd = 0; dd < 4; ++dd) kb[dd] = K_lds + KB * SHM_K + KSWZ(r32, (dd * 16 + hi * 8) * 2);
#pragma unroll
    for (int d0 = 0; d0 < 8; ++d0) { const char* a = kb[d0 & 3] + (d0 >> 2) * 128;
        bf16x8 b0 = *reinterpret_cast<const bf16x8*>(a);
        bf16x8 b1 = *reinterpret_cast<const bf16x8*>(a + 32 * 256);
        p0 = __builtin_amdgcn_mfma_f32_32x32x16_bf16(b0, qr[d0], p0, 0, 0, 0);
        p1 = __builtin_amdgcn_mfma_f32_32x32x16_bf16(b1, qr[d0], p1, 0, 0, 0); }
}
template <int VB, bool SK>
__device__ __forceinline__ void pv_tile(f32x16* o, int vb0, bf16x8 pa0, bf16x8 pa1, bf16x8 pa2, bf16x8 pa3, bool act) {
    if (SK && !act) return;
#define TRRD(dst, off) asm volatile("ds_read_b64_tr_b16 %0, %1 offset:%2" : "=&v"(dst) : "v"(vb0), "i"(off) : "memory")
#define PV_D0(d0) do { s16x4 l0, l1, l2, l3, h0, h1, h2, h3; constexpr int b_ = VB * SHM_V + v_rd_off(d0, 0, 0);     \
        TRRD(l0, b_); TRRD(h0, b_ + 2048); TRRD(l1, b_ + 4096); TRRD(h1, b_ + 6144); TRRD(l2, b_ + 8192); TRRD(h2, b_ + 10240); TRRD(l3, b_ + 12288); TRRD(h3, b_ + 14336); \
        asm volatile("s_waitcnt lgkmcnt(0)" ::: "memory"); SBAR();                 \
        o[d0] = __builtin_amdgcn_mfma_f32_32x32x16_bf16(pa0, (bf16x8){l0[0], l0[1], l0[2], l0[3], h0[0], h0[1], h0[2], h0[3]}, o[d0], 0, 0, 0);   \
        o[d0] = __builtin_amdgcn_mfma_f32_32x32x16_bf16(pa1, (bf16x8){l1[0], l1[1], l1[2], l1[3], h1[0], h1[1], h1[2], h1[3]}, o[d0], 0, 0, 0);   \
        o[d0] = __builtin_amdgcn_mfma_f32_32x32x16_bf16(pa2, (bf16x8){l2[0], l2[1], l2[2], l2[3], h2[0], h2[1], h2[2], h2[3]}, o[d0], 0, 0, 0);   \
        o[d0] = __builtin_amdgcn_mfma_f32_32x32x16_bf16(pa3, (bf16x8){l3[0], l3[1], l3[2], l3[3], h3[0], h3[1], h3[2], h3[3]}, o[d0], 0, 0, 0); } while (0)
    PV_D0(0); PV_D0(1); PV_D0(2); PV_D0(3);
#undef PV_D0
#undef TRRD
}

template <class TIn, class TOut> struct BlockRef { const TIn* Q; const TIn* K; const TIn* V; TOut* O; int P0; };
template <class TIn> struct Seam {
    bf16x8 qr[8];
    bf16x8 st_v0, st_v1, st_k0, st_k1; f32x4 sf0, sf1, sf2, sf3;
    f32x4 tq[16];
};
__device__ __forceinline__ int swa_jlo(int P0, int W) { const int lowk = P0 - W + 1; return lowk > 0 ? lowk / KVBLK : 0; }
#define ROW(p, k0, rr) ((p) + (unsigned)(((k0) + (rr)) * LD + sc))
#define VMW() asm volatile("s_waitcnt vmcnt(0)" ::: "memory")
#define VMWN(n) asm volatile("s_waitcnt vmcnt(%0)" :: "i"(n) : "memory")
#define SLOAD_H(Kp, Vp, k0) do { S.st_v0 = load8<TIn>(ROW(Vp, k0, sr)); S.st_v1 = load8<TIn>(ROW(Vp, k0, 32 + sr));              \
                         S.st_k0 = load8<TIn>(ROW(Kp, k0, sr)); S.st_k1 = load8<TIn>(ROW(Kp, k0, 32 + sr)); } while (0)
#define SWRITE_HK(bf) do { *(bf16x8*)(K_lds + (bf) * SHM_K + kws) = S.st_k0; *(bf16x8*)(K_lds + (bf) * SHM_K + kws + 32 * 256) = S.st_k1; } while (0)
#define SWRITE_HV(bf) do { *(bf16x8*)(V_lds + (bf) * SHM_V + vst0) = S.st_v0; *(bf16x8*)(V_lds + (bf) * SHM_V + vst1) = S.st_v1; } while (0)
#define SWRITE_H(bf) do { SWRITE_HV(bf); SWRITE_HK(bf); } while (0)
#define SLOAD_F(p, k0) do { S.sf0 = *(const f32x4*)ROW(p, k0, sr); S.sf1 = *(const f32x4*)(ROW(p, k0, sr) + 4);                \
                            S.sf2 = *(const f32x4*)ROW(p, k0, 32 + sr); S.sf3 = *(const f32x4*)(ROW(p, k0, 32 + sr) + 4); } while (0)
#define SWRITE_KF(bf) do { *(bf16x8*)(K_lds + (bf) * SHM_K + kws) = pack8(S.sf0, S.sf1); *(bf16x8*)(K_lds + (bf) * SHM_K + kws + 32 * 256) = pack8(S.sf2, S.sf3); } while (0)
#define SWRITE_VF(bf) do { *(bf16x8*)(V_lds + (bf) * SHM_V + vst0) = pack8(S.sf0, S.sf1); *(bf16x8*)(V_lds + (bf) * SHM_V + vst1) = pack8(S.sf2, S.sf3); } while (0)
template <class TIn, class TOut>
__device__ __forceinline__ void causal_swa_prime(const BlockRef<TIn, TOut>& cur, int W, char* lds, Seam<TIn>& S) {
    constexpr bool F32 = same_t<TIn, float>::v;
    const int tid = threadIdx.x, wid = __builtin_amdgcn_readfirstlane(tid >> 6), lane = tid & 63, r32 = lane & 31, hi = lane >> 5;
    const int sr = tid >> 4, sc = (tid & 15) * 8, kws = KSWZ(sr, sc * 2); char* K_lds = lds + 2 * SHM_V;
    const int kb0 = swa_jlo(cur.P0, W) * KVBLK;
    for (int d0 = 0; d0 < 8; ++d0) S.qr[d0] = load8<TIn>(cur.Q + (unsigned)((wid * QBLK + r32) * LD + d0 * 16 + hi * 8));
    if constexpr (F32) { SLOAD_F((const float*)cur.K, kb0); VMW(); SWRITE_KF(0); SBAR(); SLOAD_F((const float*)cur.V, kb0); }
    else { SLOAD_H(cur.K, cur.V, kb0); VMW(); SWRITE_HK(0); }
    __syncthreads();
}
template <bool LIN, class TIn, class TOut>
__device__ __forceinline__ void causal_swa_block(const BlockRef<TIn, TOut>& cur, const BlockRef<TIn, TOut>& nxt, int skv, int W, char* lds, Seam<TIn>& S) {
    constexpr bool F32 = same_t<TIn, float>::v;
    const int tid = threadIdx.x, wid = __builtin_amdgcn_readfirstlane(tid >> 6), lane = tid & 63, r32 = lane & 31, hi = lane >> 5;
    const int j_lo = swa_jlo(cur.P0, W);
    int j_hi = (cur.P0 + QB - 1) / KVBLK + 1; if (j_hi > skv / KVBLK) j_hi = skv / KVBLK;
    const int NT = j_hi - j_lo;
    const int kbn = swa_jlo(nxt.P0, W) * KVBLK;
    const int qlo = cur.P0 + wid * QBLK, qm = qlo + r32 - 4 * hi;
    char* V_lds = lds; char* K_lds = lds + 2 * SHM_V;
    float* ws = (float*)(lds + 2 * SHM_V + 2 * SHM_K) + wid * 64; float* li_l = ws, * al_l = ws + 32;
    float m_reg = -1e30f, l_reg = 0; f32x16 o[4] = {};
    const int sr = tid >> 4, sc = (tid & 15) * 8, vst0 = v_st(sr, sc), vst1 = v_st(32 + sr, sc), kws = KSWZ(sr, sc * 2);
    const int vb0 = (int)(uintptr_t)V_lds + v_rd_base(lane);
    const TIn* Kh = cur.K; const TIn* Vh = cur.V;
#define RESC(a) do { if (!LIN && __any((a) < 1.f)) { if (hi == 0) al_l[r32] = (a); asm volatile("s_waitcnt lgkmcnt(0)" ::: "memory");              \
                     for (int d_ = 0; d_ < 4; ++d_) for (int r = 0; r < 16; ++r) o[d_][r] *= al_l[crow(r, hi)]; } } while (0)
#define KBASE(t) ((j_lo + (t)) * KVBLK)
#define ACT(t) (KBASE(t) <= qlo + QBLK - 1 && KBASE(t) + KVBLK - 1 >= qlo - W + 1)
#define MASKT(P0_, P1_, t) do { const int kb_ = KBASE(t); if ((!SK || ACT(t)) && (kb_ + KVBLK - 1 > qlo || kb_ <= qlo + QBLK - 1 - W)) mask_tile<LIN>(P0_, P1_, qm - kb_, (unsigned)W); } while (0)
    constexpr int NQL = F32 ? 16 : 8;
    constexpr bool SK = WSKIP && !F32;
#define SEAM_K0() do { VMWN(NQL); if constexpr (F32) { SWRITE_KF(0); SBAR(); SLOAD_F((const float*)nxt.V, kbn); } else { SWRITE_HK(0); } SBAR(); } while (0)
    f32x16 pA0, pA1, pB0, pB1; float mnA, mnB, alA, alB; bf16x8 pa0, pa1, pa2, pa3;
    if constexpr (F32) { VMW(); SWRITE_VF(0); SBAR(); } else { SWRITE_HV(0); SBAR(); }
    if (NT > 1) { if constexpr (F32) SLOAD_F((const float*)Kh, KBASE(1)); else SLOAD_H(Kh, Vh, KBASE(1)); }
    SBAR(); qkt<0, SK>(pA0, pA1, K_lds, r32, hi, S.qr, ACT(0));
    if constexpr (F32) { if (NT > 1) { VMW(); SWRITE_KF(1); SBAR(); SLOAD_F((const float*)Vh, KBASE(1)); } }
    MASKT(pA0, pA1, 0); partialSM<LIN>(pA0, pA1, m_reg, mnA, alA);
    if (NT > 1) { VMW(); if constexpr (F32) { SWRITE_VF(1); SBAR(); if (NT > 2) SLOAD_F((const float*)Kh, KBASE(2)); } else SWRITE_H(1); }
    __syncthreads();
#define HALF_STEP(PX0, PX1, mnX, alX, PY0, PY1, alY, t, KB, VB, SB) do {                                                      \
        SBAR(); qkt<KB, SK>(PX0, PX1, K_lds, r32, hi, S.qr, ACT(t));                                             \
        finishSM<LIN>(PY0, PY1, alY, l_reg, pa0, pa1, pa2, pa3); SBAR();                                                           \
        if ((t) + 1 < NT) { if constexpr (F32) { VMW(); SWRITE_KF(SB); SBAR(); SLOAD_F((const float*)Vh, KBASE((t) + 1)); }  \
                            else { SLOAD_H(Kh, Vh, KBASE((t) + 1)); } SBAR(); }                                               \
        pv_tile<VB, SK>(o, vb0, pa0, pa1, pa2, pa3, ACT((t) - 1)); MASKT(PX0, PX1, (t)); partialSM<LIN>(PX0, PX1, m_reg, mnX, alX);                                        \
        __syncthreads();                                                                                                      \
        if ((t) + 1 < NT) { VMW(); if constexpr (F32) { SWRITE_VF(SB); SBAR(); if ((t) + 2 < NT) SLOAD_F((const float*)Kh, KBASE((t) + 2)); } \
                            else { SWRITE_H(SB); } }                                                                          \
        RESC(alX); __syncthreads(); } while (0)
    for (int t = 1; t + 1 < NT; t += 2) {
        HALF_STEP(pB0, pB1, mnB, alB, pA0, pA1, alA, t, 1, 0, 0);
        HALF_STEP(pA0, pA1, mnA, alA, pB0, pB1, alB, t + 1, 0, 1, 1);
    }
    const bool even = (NT & 1) == 0;
    if (even) { SBAR(); qkt<1, SK>(pB0, pB1, K_lds, r32, hi, S.qr, ACT(NT - 1)); SBAR(); }
#define QROW(e) (nxt.Q + (size_t)(wid * QBLK + r32) * LD + ((e) >> 1) * 16 + hi * 8 + ((e) & 1) * 4)
    if constexpr (F32) { SLOAD_F((const float*)nxt.K, kbn); SBAR();
#pragma unroll
        for (int e = 0; e < 8; ++e) S.tq[e] = *(const f32x4*)QROW(e); }
    else { SLOAD_H(nxt.K, nxt.V, kbn); SBAR();
#pragma unroll
        for (int d0 = 0; d0 < 8; ++d0) S.qr[d0] = load8<TIn>(nxt.Q + (unsigned)((wid * QBLK + r32) * LD + d0 * 16 + hi * 8)); }
    SBAR();
    finishSM<LIN>(pA0, pA1, alA, l_reg, pa0, pa1, pa2, pa3); SBAR();
    if constexpr (F32) {
#pragma unroll
        for (int e = 8; e < 16; ++e) S.tq[e] = *(const f32x4*)QROW(e); SBAR(); }
#undef QROW
    pv_tile<0, SK>(o, vb0, pa0, pa1, pa2, pa3, ACT(even ? NT - 2 : NT - 1));
    if (even) { MASKT(pB0, pB1, NT - 1); partialSM<LIN>(pB0, pB1, m_reg, mnB, alB); __syncthreads(); RESC(alB);
        finishSM<LIN>(pB0, pB1, alB, l_reg, pa0, pa1, pa2, pa3); SBAR(); pv_tile<1, SK>(o, vb0, pa0, pa1, pa2, pa3, ACT(NT - 1)); }
    SBAR(); SEAM_K0();
    if (hi == 0) li_l[r32] = l_reg; asm volatile("s_waitcnt lgkmcnt(0)" ::: "memory");
    float rli[16];
#pragma unroll
    for (int r = 0; r < 16; ++r) rli[r] = LIN ? 1.f : __builtin_amdgcn_rcpf(li_l[crow(r, hi)]);
    TOut* Ow = cur.O + (size_t)(wid * QBLK) * LD;
#pragma unroll
    for (int r = 0; r < 16; ++r) { const int orow = crow(r, hi);
#pragma unroll
        for (int d0 = 0; d0 < 4; ++d0) { const float v = o[d0][r] * rli[r];
            if constexpr (same_t<TOut, float>::v) { Ow[(size_t)orow * LD + d0 * 32 + r32] = v; }
            else { const float vn = __shfl_xor(v, 1);
                   if ((r32 & 1) == 0) *(unsigned*)(Ow + (size_t)orow * LD + d0 * 32 + r32) = cvtpk(v, vn); } } }
    if constexpr (F32) {
#pragma unroll
        for (int d0 = 0; d0 < 8; ++d0) S.qr[d0] = pack8(S.tq[2 * d0], S.tq[2 * d0 + 1]); }
    __syncthreads();
#undef RESC
#undef KBASE
#undef ACT
#undef MASKT
#undef SEAM_K0
#undef HALF_STEP
}
#undef ROW
#undef VMW
#undef VMWN
#undef SLOAD_H
#undef SWRITE_HK
#undef SWRITE_HV
#undef SWRITE_H
#undef SLOAD_F
#undef SWRITE_KF
#undef SWRITE_VF

#undef KSWZ
#undef SBAR
}
constexpr int NWAVES = 8;
constexpr int LDS_BYTES = 147456;
static_assert(pg8::STAGE_BYTES <= LDS_BYTES && att::ATT_LDS_BYTES <= LDS_BYTES, "LDS map");

typedef att::BlockRef<att::bf16, att::bf16> ABlock;
__device__ __forceinline__ ABlock attn_ref(unsigned char* ws, int vcu, int G, int nd, int s, bool& lin) {
    const int it = s >> 1, pass = s & 1; ABlock r;
    if (it < nd) {
        const int id = vcu + it * G, x = id & 3, vh = (id >> 2) & 1, hc = (id >> 3) & 15, b = id >> 7, qb = pass ? 7 - x : x;
        const size_t rb = (size_t)b * SEQ * 2048, rq = rb + (size_t)qb * 256 * 2048;
        r.Q = (const att::bf16*)(ws + WS_DQ) + rq + hc * 128; r.K = (const att::bf16*)(ws + WS_DK) + rb + hc * 128;
        r.V = (const att::bf16*)(ws + WS_DV) + rb + (hc >> 1) * 256 + vh * 128;
        r.O = (att::bf16*)(ws + ((hc & 1) ? WS_O2 : WS_O1)) + rq + (hc >> 1) * 256 + vh * 128; r.P0 = qb * 256; lin = false;
    } else {
        const int id = vcu + (it - nd) * G, x = id & 3, vh = (id >> 2) & 1, h = (id >> 3) & 7, b = id >> 6, qb = pass ? 7 - x : x;
        const size_t rb = (size_t)b * SEQ * 2048, rq = rb + (size_t)qb * 256 * 2048;
        r.Q = (const att::bf16*)(ws + WS_RQK) + rq + h * 128; r.K = (const att::bf16*)(ws + WS_RQK) + rb + 1024 + h * 128;
        r.V = (const att::bf16*)(ws + WS_RV) + rb + h * 256 + vh * 128;
        r.O = (att::bf16*)(ws + WS_ORET) + rq + h * 256 + vh * 128; r.P0 = qb * 256; lin = true;
    }
    return r;
}
__device__ __forceinline__ void attn_phase(unsigned char* ws, char* lds, int vcu, int G) {
    const int nd = vcu < 512 ? (512 - vcu + G - 1) / G : 0, nr = vcu < 256 ? (256 - vcu + G - 1) / G : 0, total = 2 * (nd + nr);
    if (total == 0) return;
    bool lin_cur, lin_nxt;
    ABlock cur = attn_ref(ws, vcu, G, nd, 0, lin_cur);
    att::Seam<att::bf16> S;
    att::causal_swa_prime<att::bf16, att::bf16>(cur, SEQ, lds, S);
    int s = 0;
    for (; s < 2 * nd; ++s) {
        ABlock nxt = cur; if (s + 1 < total) nxt = attn_ref(ws, vcu, G, nd, s + 1, lin_nxt);
        att::causal_swa_block<false, att::bf16, att::bf16>(cur, nxt, SEQ, SEQ, lds, S); cur = nxt;
    }
    for (; s < total; ++s) {
        ABlock nxt = cur; if (s + 1 < total) nxt = attn_ref(ws, vcu, G, nd, s + 1, lin_nxt);
        att::causal_swa_block<true, att::bf16, att::bf16>(cur, nxt, SEQ, SEQ, lds, S); cur = nxt;
    }
}

#ifndef PG8_SP2
#define PG8_SP2 true
#endif
#ifndef PG8_ALIGN
#define PG8_ALIGN true
#endif
constexpr int N_PHASES = 7;
__global__ void __launch_bounds__(NWAVES * 64, 2) k_mega(Ptrs P, int ph_lo, int ph_hi) {
    extern __shared__ __attribute__((aligned(16))) unsigned char lds[];
    cg::grid_group grid = cg::this_grid();
    const int tid = threadIdx.x, lane = tid & 63, wave = __builtin_amdgcn_readfirstlane(tid >> 6);
    const int G = gridDim.x, bx = blockIdx.x, vcu = (G % 8 == 0) ? (bx % 8) * (G / 8) + bx / 8 : bx;
    const int gw = vcu * NWAVES + wave, NGW = G * NWAVES;
    unsigned char* ws = P.ws;
    LAS unsigned char* lds3 = (LAS unsigned char*)lds;
#ifndef PHASE_MASK
#define PHASE_MASK 0x7f
#endif
#define IN(k) (((PHASE_MASK >> (k)) & 1) && ph_lo <= (k) && (k) < ph_hi)
#define SEAM(k) do { if (IN(k) && IN((k) + 1)) grid.sync(); } while (0)
    if (IN(0)) p0_prologue(P, (LAS float*)(lds3 + wave * 16384), gw, NGW, lane);
    SEAM(0);
    if (IN(1)) { pg8::Gemm g{(const bf16_t*)(ws + WS_XN), (const bf16_t*)(ws + WS_WINT), M, NIN, DM}; pg8::StaticOrder S; S.init(M, NIN, G, bx);
        pg8::EpiIn E{ws}; pg8::gemm_phase<pg8::EpiIn, pg8::StaticOrder, PG8_ALIGN, PG8_SP2>(lds3, g, S, E); }
    SEAM(1);
    if (IN(2)) attn_phase(ws, (char*)lds, vcu, G);
    SEAM(2);
    if (IN(3)) post_rows(P, gw, NGW, lane);
    SEAM(3);
    if (IN(4)) {
        { pg8::Gemm g{(const bf16_t*)(ws + WS_AR), (const bf16_t*)(ws + WS_WRUT), M, DM, DM}; pg8::StaticOrder S; S.init(M, DM, G, bx);
          pg8::EpiUp<1> E{ws}; pg8::gemm_phase<pg8::EpiUp<1>, pg8::StaticOrder, PG8_ALIGN, PG8_SP2>(lds3, g, S, E); }
        { pg8::Gemm g{(const bf16_t*)(ws + WS_AD), (const bf16_t*)(ws + WS_WDUT), M, DM, DM}; pg8::StaticOrder S; S.init(M, DM, G, bx);
          pg8::EpiUp<2> E{ws}; pg8::gemm_phase<pg8::EpiUp<2>, pg8::StaticOrder, PG8_ALIGN, PG8_SP2>(lds3, g, S, E); }
    }
    SEAM(4);
    if (IN(5)) { pg8::Gemm g{(const bf16_t*)(ws + WS_MIX), (const bf16_t*)(ws + WS_WOUTT), M, DM, DM}; pg8::StaticOrder S; S.init(M, DM, G, bx);
        pg8::EpiOut E{P.x, P.out, (float*)(ws + WS_SS)}; pg8::gemm_phase<pg8::EpiOut, pg8::StaticOrder, PG8_ALIGN, PG8_SP2>(lds3, g, S, E); }
    SEAM(5);
    if (IN(6)) final_rows(P, gw, NGW, lane);
#undef IN
#undef SEAM
}
static void opt_launch(const Ptrs& P, hipStream_t stream) {
    static int grid = 0;
    if (grid == 0) {
        int dev = 0, cus = 0, per_cu = 0;
        (void)hipGetDevice(&dev); (void)hipDeviceGetAttribute(&cus, hipDeviceAttributeMultiprocessorCount, dev);
        if (hipFuncSetAttribute((const void*)k_mega, hipFuncAttributeMaxDynamicSharedMemorySize, LDS_BYTES) != hipSuccess) { fprintf(stderr, "hipFuncSetAttribute failed\n"); grid = -1; return; }
        if (hipOccupancyMaxActiveBlocksPerMultiprocessor(&per_cu, (const void*)k_mega, NWAVES * 64, LDS_BYTES) != hipSuccess || per_cu < 1) { fprintf(stderr, "occupancy query: %d blocks per CU\n", per_cu); grid = -1; return; }
        grid = cus;
        fprintf(stderr, "k_mega: grid %d (cus %d, per_cu %d)\n", grid, cus, per_cu);
    }
    if (grid < 0) return;
#if MODE == 2
    Ptrs p = P; int lo = 0, hi = N_PHASES; void* args[] = {&p, &lo, &hi};
    hipError_t e = hipLaunchCooperativeKernel((const void*)k_mega, dim3(grid), dim3(NWAVES * 64), args, LDS_BYTES, stream);
    if (e != hipSuccess) fprintf(stderr, "cooperative launch failed: %s (grid %d)\n", hipGetErrorString(e), grid);
#else
    for (int ph = 0; ph < N_PHASES; ++ph) hipLaunchKernelGGL(k_mega, dim3(grid), dim3(NWAVES * 64), LDS_BYTES, stream, P, ph, ph + 1);
#endif
}
#endif
extern "C" void kernel_launch(void* const* d_in, const int* in_sizes, int n_in, void* d_out, int out_size, void* d_ws, size_t ws_size, hipStream_t stream) {
    static int ok = 0;
    if (ok == 0) {
        ok = 1;
        if (n_in != 12 || in_sizes[0] != M * DM || in_sizes[2] != DM * NIN || out_size != M * DM || ws_size < WS_END) {
            fprintf(stderr, "kernel_launch: unexpected shapes (n_in %d in0 %d in2 %d out %d ws %zu); nothing launched\n", n_in, n_in > 0 ? in_sizes[0] : -1, n_in > 2 ? in_sizes[2] : -1, out_size, ws_size); ok = -1; }
    }
    if (ok < 0) return;
    Ptrs P{};
    P.x = (const float*)d_in[0]; P.norm_w = (const float*)d_in[1]; P.w_in = (const float*)d_in[2]; P.w_ret_up = (const float*)d_in[3]; P.w_diff_up = (const float*)d_in[4];
    P.w_out = (const float*)d_in[5]; P.lq1 = (const float*)d_in[6]; P.lk1 = (const float*)d_in[7]; P.lq2 = (const float*)d_in[8]; P.lk2 = (const float*)d_in[9];
    P.subln_w = (const float*)d_in[10]; P.final_w = (const float*)d_in[11]; P.out = (float*)d_out; P.ws = (unsigned char*)d_ws;
#if MODE == 0
    naive::launch_all(P, stream);
#else
    opt_launch(P, stream);
#endif
}
```

```cpp
#define MODE 2
#include <hip/hip_runtime.h>
#include <hip/hip_cooperative_groups.h>
#include <hip/hip_bf16.h>
#include <cstdio>
#include <cstdint>
namespace cg = cooperative_groups;

#ifndef MODE
#define MODE 0
#endif

constexpr int BATCH = 4, SEQ = 2048, DM = 2048, M = BATCH * SEQ, NIN = 18432;
constexpr float NORM_EPS = 1e-6f, SUBLN_EPS = 1e-5f, LAM_INIT = 0.2f;
constexpr float QK_SCALE = 0.08838834764831845f;

constexpr size_t MiB = 1u << 20;
constexpr size_t WS_CTL = 0;
constexpr size_t WS_COSR = 1 * MiB, WS_SINR = WS_COSR + 512 * 1024, WS_COSD = 2 * MiB, WS_SIND = WS_COSD + 512 * 1024;
constexpr size_t WS_SS = 3 * MiB;
constexpr size_t WS_WRUT = 4 * MiB, WS_WDUT = 12 * MiB, WS_WOUTT = 20 * MiB;
constexpr size_t WS_WINT = 32 * MiB;
constexpr size_t WS_XN = 104 * MiB;
constexpr size_t WS_RQK = 136 * MiB;
constexpr size_t WS_RV = 168 * MiB, WS_SRZ = 200 * MiB, WS_DQ = 232 * MiB, WS_DK = 264 * MiB, WS_DV = 296 * MiB, WS_SDZ = 328 * MiB, WS_SGR = 360 * MiB, WS_SGD = 392 * MiB;
constexpr size_t WS_END = 424 * MiB;
constexpr size_t WS_ORET = 32 * MiB, WS_O1 = 64 * MiB, WS_O2 = 96 * MiB;
constexpr size_t WS_AR = 136 * MiB, WS_AD = 168 * MiB;
constexpr size_t WS_T = 232 * MiB;
constexpr size_t WS_MIX = 296 * MiB;

typedef unsigned short bf16_t;
typedef short bf16x8 __attribute__((ext_vector_type(8)));
typedef float f32x4 __attribute__((ext_vector_type(4)));
typedef float f32x2 __attribute__((ext_vector_type(2)));
typedef unsigned u32x4 __attribute__((ext_vector_type(4)));
typedef unsigned u32x2 __attribute__((ext_vector_type(2)));
#define LAS __attribute__((address_space(3)))

struct Ptrs {
    const float *x, *norm_w, *w_in, *w_ret_up, *w_diff_up, *w_out, *lq1, *lk1, *lq2, *lk2, *subln_w, *final_w;
    float* out; unsigned char* ws;
};

__device__ __forceinline__ unsigned f2bf(float f) { unsigned u = __builtin_bit_cast(unsigned, f); return (u + 0x7fffu + ((u >> 16) & 1u)) >> 16; }
__device__ __forceinline__ unsigned pk2(float lo, float hi) { return f2bf(lo) | (f2bf(hi) << 16); }
__device__ __forceinline__ float bflo(unsigned w) { return __builtin_bit_cast(float, w << 16); }
__device__ __forceinline__ float bfhi(unsigned w) { return __builtin_bit_cast(float, w & 0xffff0000u); }
__device__ __forceinline__ u32x4 pack8f(f32x4 a, f32x4 b) { u32x4 w; w.x = pk2(a[0], a[1]); w.y = pk2(a[2], a[3]); w.z = pk2(b[0], b[1]); w.w = pk2(b[2], b[3]); return w; }
__device__ __forceinline__ void unpack8f(u32x4 w, f32x4& a, f32x4& b) { a = (f32x4){bflo(w.x), bfhi(w.x), bflo(w.y), bfhi(w.y)}; b = (f32x4){bflo(w.z), bfhi(w.z), bflo(w.w), bfhi(w.w)}; }
__device__ __forceinline__ float sigmoidf_(float v) { return __builtin_amdgcn_rcpf(1.0f + __builtin_amdgcn_exp2f(-1.4426950408889634f * v)); }
__device__ __forceinline__ float wave_sum(float v) {
#pragma unroll
    for (int o = 1; o < 64; o <<= 1) v += __shfl_xor(v, o);
    return v;
}

__device__ __forceinline__ void epi_in8(unsigned char* ws, int row, int pn, int lcol, f32x4 a, f32x4 b) {
    const int t = row & (SEQ - 1);
    bf16_t* dst; int col;
    if (pn < 8 || (pn >= 24 && pn < 40)) {
        const bool ret = pn < 8;
        const int g = (lcol & 127) >> 3;
        const float* ct = (const float*)(ws + (ret ? WS_COSR : WS_COSD)) + t * 64 + 4 * g;
        const float* st = (const float*)(ws + (ret ? WS_SINR : WS_SIND)) + t * 64 + 4 * g;
        const f32x4 c = *(const f32x4*)ct, s = *(const f32x4*)st;
        f32x4 o1 = a * c - b * s, o2 = b * c + a * s;
        if (ret) {
            const int h = 2 * (pn & 3) + (lcol >> 7);
            const float l2g = ((const float*)(ws + WS_CTL))[16 + h];
            const float e = (float)(t - 1024) * l2g;
            const float sc = (pn >= 4) ? __builtin_amdgcn_exp2f(-e) * QK_SCALE : __builtin_amdgcn_exp2f(e);
            o1 = o1 * sc; o2 = o2 * sc;
            dst = (bf16_t*)(ws + WS_RQK); col = pn * 256 + lcol;
        } else if (pn < 32) { dst = (bf16_t*)(ws + WS_DQ); col = (pn - 24) * 256 + lcol; }
        else { dst = (bf16_t*)(ws + WS_DK); col = (pn - 32) * 256 + lcol; }
        *(u32x4*)(dst + (size_t)row * 2048 + col) = pack8f(o1, o2);
        return;
    }
    if (pn < 16) { dst = (bf16_t*)(ws + WS_RV); col = (pn - 8) * 256 + lcol; }
    else if (pn < 24) { dst = (bf16_t*)(ws + WS_SRZ); col = (pn - 16) * 256 + lcol;
#pragma unroll
        for (int i = 0; i < 4; ++i) { a[i] = a[i] * sigmoidf_(a[i]); b[i] = b[i] * sigmoidf_(b[i]); } }
    else if (pn < 48) { dst = (bf16_t*)(ws + WS_DV); col = (pn - 40) * 256 + lcol; }
    else if (pn < 56) { dst = (bf16_t*)(ws + WS_SDZ); col = (pn - 48) * 256 + lcol;
#pragma unroll
        for (int i = 0; i < 4; ++i) { a[i] = a[i] * sigmoidf_(a[i]); b[i] = b[i] * sigmoidf_(b[i]); } }
    else { dst = (bf16_t*)(ws + (pn < 64 ? WS_SGR : WS_SGD)); col = ((pn - 56) & 7) * 256 + lcol;
#pragma unroll
        for (int i = 0; i < 4; ++i) { a[i] = sigmoidf_(a[i]); b[i] = sigmoidf_(b[i]); } }
    *(u32x4*)(dst + (size_t)row * 2048 + col) = pack8f(a, b);
}
__device__ __forceinline__ void epi_up1_8(unsigned char* ws, int row, int col, f32x4 a, f32x4 b) {
    f32x4 ga, gb; unpack8f(*(const u32x4*)((const bf16_t*)(ws + WS_SGR) + (size_t)row * 2048 + col), ga, gb);
    float* T = (float*)(ws + WS_T) + (size_t)row * 2048 + col;
    *(f32x4*)T = a * ga; *(f32x4*)(T + 4) = b * gb;
}
__device__ __forceinline__ void epi_up2_8(unsigned char* ws, int row, int col, f32x4 a, f32x4 b) {
    f32x4 ga, gb; unpack8f(*(const u32x4*)((const bf16_t*)(ws + WS_SGD) + (size_t)row * 2048 + col), ga, gb);
    const float* T = (const float*)(ws + WS_T) + (size_t)row * 2048 + col;
    const f32x4 ta = *(const f32x4*)T, tb = *(const f32x4*)(T + 4);
    *(u32x4*)((bf16_t*)(ws + WS_MIX) + (size_t)row * 2048 + col) = pack8f(ta + a * ga, tb + b * gb);
}

__device__ __forceinline__ int win_dst_row(int c) {
    const bool qk = (c < 2048) || (c >= 6144 && c < 10240);
    const int d = c & 127, p = 8 * ((d & 63) >> 2) + 4 * (d >> 6) + (d & 3);
    return qk ? (c & ~127) + p : c;
}
template <bool PERMQK>
__device__ __forceinline__ void p0_transpose_item(const float* W, int K, int N, bf16_t* WT, LAS float* scr, int item, int lane) {
    const int nblk = N / 32, kb = item / nblk, nb = item % nblk, k0 = 64 * kb, n0 = 32 * nb;
#pragma unroll 8
    for (int i = 0; i < 32; ++i) { const int kk = 2 * i + (lane >> 5); scr[kk * 33 + (lane & 31)] = W[(size_t)(k0 + kk) * N + n0 + (lane & 31)]; }
    asm volatile("s_waitcnt lgkmcnt(0)" ::: "memory");
    const int c = lane & 7;
#pragma unroll
    for (int j = 0; j < 4; ++j) { const int n = (lane >> 3) + 8 * j; const LAS float* s = scr + (8 * c) * 33 + n;
        u32x4 o; o.x = pk2(s[0 * 33], s[1 * 33]); o.y = pk2(s[2 * 33], s[3 * 33]); o.z = pk2(s[4 * 33], s[5 * 33]); o.w = pk2(s[6 * 33], s[7 * 33]);
        const int drow = PERMQK ? win_dst_row(n0 + n) : (n0 + n);
        *(u32x4*)(WT + (size_t)drow * K + k0 + 8 * c) = o; }
    asm volatile("s_waitcnt lgkmcnt(0)" ::: "memory");
}
__device__ __forceinline__ void p0_prologue(const Ptrs& P, LAS float* scr, int gw, int NGW, int lane) {
    unsigned char* ws = P.ws;
    constexpr int I_IN = (DM / 64) * (NIN / 32), I_SQ = (DM / 64) * (DM / 32);
    for (int it = gw; it < I_IN + 3 * I_SQ; it += NGW) {
        int r = it;
        if (r < I_IN) { p0_transpose_item<true>(P.w_in, DM, NIN, (bf16_t*)(ws + WS_WINT), scr, r, lane); continue; } r -= I_IN;
        if (r < I_SQ) { p0_transpose_item<false>(P.w_ret_up, DM, DM, (bf16_t*)(ws + WS_WRUT), scr, r, lane); continue; } r -= I_SQ;
        if (r < I_SQ) { p0_transpose_item<false>(P.w_diff_up, DM, DM, (bf16_t*)(ws + WS_WDUT), scr, r, lane); continue; } r -= I_SQ;
        p0_transpose_item<false>(P.w_out, DM, DM, (bf16_t*)(ws + WS_WOUTT), scr, r, lane);
    }
    for (int m = gw; m < M; m += NGW) {
        const f32x4* xr = (const f32x4*)(P.x + (size_t)m * DM) + lane; const f32x4* wr_ = (const f32x4*)P.norm_w + lane;
        f32x4 v[8]; float s = 0.f;
#pragma unroll
        for (int j = 0; j < 8; ++j) { v[j] = xr[64 * j]; s += (v[j][0] * v[j][0] + v[j][1] * v[j][1]) + (v[j][2] * v[j][2] + v[j][3] * v[j][3]); }
        const float rstd = 1.0f / sqrtf(wave_sum(s) * (1.0f / DM) + NORM_EPS);
        u32x2* o8 = (u32x2*)((bf16_t*)(ws + WS_XN) + (size_t)m * DM) + lane;
#pragma unroll
        for (int j = 0; j < 8; ++j) { const f32x4 w = wr_[64 * j]; u32x2 o; o.x = pk2(v[j][0] * rstd * w[0], v[j][1] * rstd * w[1]); o.y = pk2(v[j][2] * rstd * w[2], v[j][3] * rstd * w[3]); o8[64 * j] = o; }
    }
    for (int i = gw * 64 + lane; i < SEQ * 64; i += NGW * 64) {
        const int t = i >> 6, f = i & 63;
#pragma unroll
        for (int which = 0; which < 2; ++which) {
            const double ex = which == 0 ? (double)f / 63.0 : (double)f / 64.0;
            const float inv = (float)exp(-9.210340371976184 * ex);
            const float ang = (float)t * inv;
            const double rev = (double)ang * 0.15915494309189535; const double fr = rev - floor(rev);
            const float a = (float)(fr * 6.283185307179586);
            ((float*)(ws + (which == 0 ? WS_COSR : WS_COSD)))[i] = cosf(a);
            ((float*)(ws + (which == 0 ? WS_SINR : WS_SIND)))[i] = sinf(a);
        }
    }
    if (gw == 0) {
        float* ctl = (float*)(ws + WS_CTL);
        const float s1 = wave_sum(P.lq1[lane] * P.lk1[lane] + P.lq1[lane + 64] * P.lk1[lane + 64]);
        const float s2 = wave_sum(P.lq2[lane] * P.lk2[lane] + P.lq2[lane + 64] * P.lk2[lane + 64]);
        if (lane == 0) ctl[0] = expf(s1) - expf(s2) + LAM_INIT;
        if (lane < 8) ctl[16 + lane] = (float)log2(1.0 - exp2(-5.0 - (double)lane));
    }
}
__device__ __forceinline__ void post_rows(const Ptrs& P, int gw, int NGW, int lane) {
    unsigned char* ws = P.ws;
    const float lam = ((const float*)(ws + WS_CTL))[0];
    const int cw = (lane & 7) * 32;
    for (int m = gw; m < M; m += NGW) {
        const size_t off = (size_t)m * 2048 + lane * 32;
        {
            f32x4 o[8]; float s = 0.f;
#pragma unroll
            for (int j = 0; j < 4; ++j) { unpack8f(*(const u32x4*)((const bf16_t*)(ws + WS_ORET) + off + 8 * j), o[2 * j], o[2 * j + 1]); }
#pragma unroll
            for (int j = 0; j < 8; ++j) s += (o[j][0] * o[j][0] + o[j][1] * o[j][1]) + (o[j][2] * o[j][2] + o[j][3] * o[j][3]);
            s += __shfl_xor(s, 1); s += __shfl_xor(s, 2); s += __shfl_xor(s, 4);
            const float rstd = 1.0f / sqrtf(s * (1.0f / 256.0f) + NORM_EPS);
#pragma unroll
            for (int j = 0; j < 4; ++j) { f32x4 za, zb; unpack8f(*(const u32x4*)((const bf16_t*)(ws + WS_SRZ) + off + 8 * j), za, zb);
                *(u32x4*)((bf16_t*)(ws + WS_AR) + off + 8 * j) = pack8f(o[2 * j] * rstd * za, o[2 * j + 1] * rstd * zb); }
        }
        {
            f32x4 d[8]; float s = 0.f;
#pragma unroll
            for (int j = 0; j < 4; ++j) { f32x4 a1, b1, a2, b2; unpack8f(*(const u32x4*)((const bf16_t*)(ws + WS_O1) + off + 8 * j), a1, b1); unpack8f(*(const u32x4*)((const bf16_t*)(ws + WS_O2) + off + 8 * j), a2, b2);
                d[2 * j] = a1 - a2 * lam; d[2 * j + 1] = b1 - b2 * lam; }
#pragma unroll
            for (int j = 0; j < 8; ++j) s += (d[j][0] * d[j][0] + d[j][1] * d[j][1]) + (d[j][2] * d[j][2] + d[j][3] * d[j][3]);
            s += __shfl_xor(s, 1); s += __shfl_xor(s, 2); s += __shfl_xor(s, 4);
            const float rstd = (1.0f - LAM_INIT) / sqrtf(s * (1.0f / 256.0f) + SUBLN_EPS);
#pragma unroll
            for (int j = 0; j < 4; ++j) { f32x4 za, zb; unpack8f(*(const u32x4*)((const bf16_t*)(ws + WS_SDZ) + off + 8 * j), za, zb);
                const f32x4 wa = *(const f32x4*)(P.subln_w + cw + 8 * j), wb = *(const f32x4*)(P.subln_w + cw + 8 * j + 4);
                *(u32x4*)((bf16_t*)(ws + WS_AD) + off + 8 * j) = pack8f(d[2 * j] * rstd * wa * za, d[2 * j + 1] * rstd * wb * zb); }
        }
    }
}
__device__ __forceinline__ void final_rows(const Ptrs& P, int gw, int NGW, int lane) {
    for (int m = gw; m < M; m += NGW) {
        const float part = ((const float*)(P.ws + WS_SS))[(size_t)m * 32 + (lane & 31)];
        const float tot = wave_sum(part) * 0.5f;
        const float rstd = 1.0f / sqrtf(tot * (1.0f / DM) + NORM_EPS);
        f32x4* hr = (f32x4*)(P.out + (size_t)m * DM) + lane; const f32x4* wr_ = (const f32x4*)P.final_w + lane;
#pragma unroll
        for (int j = 0; j < 8; ++j) { const f32x4 h = hr[64 * j]; hr[64 * j] = h * rstd * wr_[64 * j]; }
    }
}
namespace naive {
__global__ void __launch_bounds__(256) k_prologue(Ptrs P) {
    __shared__ float scr_all[4 * 64 * 33];
    const int lane = threadIdx.x & 63, wave = threadIdx.x >> 6;
    p0_prologue(P, (LAS float*)(scr_all + wave * 64 * 33), blockIdx.x * 4 + wave, gridDim.x * 4, lane);
}
__global__ void __launch_bounds__(512) k_post(Ptrs P) { post_rows(P, blockIdx.x * 8 + (threadIdx.x >> 6), gridDim.x * 8, threadIdx.x & 63); }
__global__ void __launch_bounds__(512) k_final(Ptrs P) { final_rows(P, blockIdx.x * 8 + (threadIdx.x >> 6), gridDim.x * 8, threadIdx.x & 63); }

template <int WHICH>
__global__ void __launch_bounds__(256) k_gemm(Ptrs P, const bf16_t* A, const bf16_t* Bt, int K) {
    __shared__ float As[32][68];
    __shared__ float Bs[32][132];
    const int tid = threadIdx.x, ty = tid >> 4, tx = tid & 15;
    const int m0 = blockIdx.y * 64, n0 = blockIdx.x * 128;
    float acc[4][8];
#pragma unroll
    for (int i = 0; i < 4; ++i)
#pragma unroll
        for (int j = 0; j < 8; ++j) acc[i][j] = 0.f;
    for (int k0 = 0; k0 < K; k0 += 32) {
        { const int r = tid >> 2, ks = (tid & 3) * 8; const u32x4 w = *(const u32x4*)(A + (size_t)(m0 + r) * K + k0 + ks); f32x4 a, b; unpack8f(w, a, b);
#pragma unroll
          for (int j = 0; j < 4; ++j) { As[ks + j][r] = a[j]; As[ks + 4 + j][r] = b[j]; } }
        { const int r = tid >> 1, ks = (tid & 1) * 16;
#pragma unroll
          for (int h = 0; h < 2; ++h) { const u32x4 w = *(const u32x4*)(Bt + (size_t)(n0 + r) * K + k0 + ks + 8 * h); f32x4 a, b; unpack8f(w, a, b);
#pragma unroll
              for (int j = 0; j < 4; ++j) { Bs[ks + 8 * h + j][r] = a[j]; Bs[ks + 8 * h + 4 + j][r] = b[j]; } } }
        __syncthreads();
#pragma unroll 8
        for (int kk = 0; kk < 32; ++kk) {
            const f32x4 av = *(const f32x4*)&As[kk][4 * ty]; const f32x4 b0 = *(const f32x4*)&Bs[kk][8 * tx], b1 = *(const f32x4*)&Bs[kk][8 * tx + 4];
#pragma unroll
            for (int i = 0; i < 4; ++i) {
#pragma unroll
                for (int j = 0; j < 4; ++j) { acc[i][j] += av[i] * b0[j]; acc[i][4 + j] += av[i] * b1[j]; } }
        }
        __syncthreads();
    }
#pragma unroll
    for (int i = 0; i < 4; ++i) {
        const int row = m0 + 4 * ty + i, col = n0 + 8 * tx;
        f32x4 a = {acc[i][0], acc[i][1], acc[i][2], acc[i][3]}, b = {acc[i][4], acc[i][5], acc[i][6], acc[i][7]};
        if (WHICH == 0) epi_in8(P.ws, row, col >> 8, col & 255, a, b);
        if (WHICH == 1) epi_up1_8(P.ws, row, col, a, b);
        if (WHICH == 2) epi_up2_8(P.ws, row, col, a, b);
        if (WHICH == 3) {
            const f32x4 xa = *(const f32x4*)(P.x + (size_t)row * DM + col), xb = *(const f32x4*)(P.x + (size_t)row * DM + col + 4);
            a = a + xa; b = b + xb;
            *(f32x4*)(P.out + (size_t)row * DM + col) = a; *(f32x4*)(P.out + (size_t)row * DM + col + 4) = b;
            float s = (a[0] * a[0] + a[1] * a[1]) + (a[2] * a[2] + a[3] * a[3]) + (b[0] * b[0] + b[1] * b[1]) + (b[2] * b[2] + b[3] * b[3]);
            s += __shfl_xor(s, 1); s += __shfl_xor(s, 2); s += __shfl_xor(s, 4);
            if ((tx & 7) == 0) ((float*)(P.ws + WS_SS))[(size_t)row * 32 + blockIdx.x * 2 + (tx >> 3)] = s;
        }
    }
}
template <int KIND>
__global__ void __launch_bounds__(256) k_attn(Ptrs P) {
    __shared__ float q[256];
    __shared__ float sc[2][SEQ];
    __shared__ float red[8];
    unsigned char* ws = P.ws;
    const int tid = threadIdx.x, t = blockIdx.x, h = blockIdx.y, b = blockIdx.z;
    const size_t rowq = (size_t)(b * SEQ + t) * 2048;
    const bf16_t* Qb = KIND == 0 ? (const bf16_t*)(ws + WS_DQ) + h * 256 : (const bf16_t*)(ws + WS_RQK) + h * 128;
    const bf16_t* Kb = KIND == 0 ? (const bf16_t*)(ws + WS_DK) + h * 256 : (const bf16_t*)(ws + WS_RQK) + 1024 + h * 128;
    const bf16_t* Vb = (const bf16_t*)(ws + (KIND == 0 ? WS_DV : WS_RV)) + h * 256;
    constexpr int NC = KIND == 0 ? 2 : 1;
    if (tid < 128 * NC) q[tid] = __builtin_bit_cast(float, (unsigned)Qb[rowq + tid] << 16);
    __syncthreads();
    for (int s = tid; s <= t; s += 256) {
        const bf16_t* kr = Kb + (size_t)(b * SEQ + s) * 2048;
#pragma unroll
        for (int c = 0; c < NC; ++c) { float d = 0.f;
            for (int i = 0; i < 128; i += 8) { f32x4 ka, kb2; unpack8f(*(const u32x4*)(kr + c * 128 + i), ka, kb2);
                d += ka[0] * q[c * 128 + i] + ka[1] * q[c * 128 + i + 1] + ka[2] * q[c * 128 + i + 2] + ka[3] * q[c * 128 + i + 3]
                   + kb2[0] * q[c * 128 + i + 4] + kb2[1] * q[c * 128 + i + 5] + kb2[2] * q[c * 128 + i + 6] + kb2[3] * q[c * 128 + i + 7]; }
            sc[c][s] = KIND == 0 ? d * QK_SCALE : d; }
    }
    __syncthreads();
    float linv[2] = {1.f, 1.f};
    if (KIND == 0) {
#pragma unroll
        for (int c = 0; c < 2; ++c) {
            float mx = -3.0e38f; for (int s = tid; s <= t; s += 256) mx = fmaxf(mx, sc[c][s]);
#pragma unroll
            for (int o = 1; o < 64; o <<= 1) mx = fmaxf(mx, __shfl_xor(mx, o));
            if ((tid & 63) == 0) red[tid >> 6] = mx; __syncthreads();
            mx = fmaxf(fmaxf(red[0], red[1]), fmaxf(red[2], red[3])); __syncthreads();
            float sm = 0.f; for (int s = tid; s <= t; s += 256) { const float p = expf(sc[c][s] - mx); sc[c][s] = p; sm += p; }
            sm = wave_sum(sm);
            if ((tid & 63) == 0) red[4 + (tid >> 6)] = sm; __syncthreads();
            linv[c] = 1.0f / (red[4] + red[5] + red[6] + red[7]); __syncthreads();
        }
    }
    float o0 = 0.f, o1 = 0.f;
    for (int s = 0; s <= t; ++s) { const float v = __builtin_bit_cast(float, (unsigned)Vb[(size_t)(b * SEQ + s) * 2048 + tid] << 16); o0 += sc[0][s] * v; if (KIND == 0) o1 += sc[1][s] * v; }
    if (KIND == 0) { ((bf16_t*)(ws + WS_O1))[rowq + h * 256 + tid] = (bf16_t)f2bf(o0 * linv[0]); ((bf16_t*)(ws + WS_O2))[rowq + h * 256 + tid] = (bf16_t)f2bf(o1 * linv[1]); }
    else ((bf16_t*)(ws + WS_ORET))[rowq + h * 256 + tid] = (bf16_t)f2bf(o0);
}
static void launch_all(const Ptrs& P, hipStream_t stream) {
    unsigned char* ws = P.ws;
    k_prologue<<<512, 256, 0, stream>>>(P);
    k_gemm<0><<<dim3(NIN / 128, M / 64), 256, 0, stream>>>(P, (const bf16_t*)(ws + WS_XN), (const bf16_t*)(ws + WS_WINT), DM);
    k_attn<0><<<dim3(SEQ, 8, BATCH), 256, 0, stream>>>(P);
    k_attn<1><<<dim3(SEQ, 8, BATCH), 256, 0, stream>>>(P);
    k_post<<<256, 512, 0, stream>>>(P);
    k_gemm<1><<<dim3(DM / 128, M / 64), 256, 0, stream>>>(P, (const bf16_t*)(ws + WS_AR), (const bf16_t*)(ws + WS_WRUT), DM);
    k_gemm<2><<<dim3(DM / 128, M / 64), 256, 0, stream>>>(P, (const bf16_t*)(ws + WS_AD), (const bf16_t*)(ws + WS_WDUT), DM);
    k_gemm<3><<<dim3(DM / 128, M / 64), 256, 0, stream>>>(P, (const bf16_t*)(ws + WS_MIX), (const bf16_t*)(ws + WS_WOUTT), DM);
    k_final<<<256, 512, 0, stream>>>(P);
}
}
#if MODE != 0
namespace pg8 {
#define PG8_LAS __attribute__((address_space(3)))
typedef unsigned short bf16_t;
typedef short bf16x8 __attribute__((ext_vector_type(8)));
typedef float f32x4 __attribute__((ext_vector_type(4)));
typedef unsigned u32x4 __attribute__((ext_vector_type(4)));
constexpr int BM = 256, BK = 64, HALF = 128, HTB = HALF * BK * 2  , STAGE_BYTES = 8 * HTB, NXCD = 8, WGM = 8;

__host__ __device__ __forceinline__ int lds_byte(int r, int c) { const int st = (r >> 4) * 2 + (c >> 5), rr = r & 15, cc = c & 31, ob = rr * 64 + cc * 2; return st * 1024 + (ob ^ (((ob >> 9) & 1) << 5)); }
__host__ __device__ __forceinline__ void stage_rc(int b, int& R, int& C) { const int st = b / 1024, sb = b % 1024, swz = sb ^ (((sb >> 9) & 1) << 5); R = (st >> 1) * 16 + swz / 64; C = (st & 1) * 32 + (swz % 64) / 2; }
__host__ __device__ __forceinline__ int perm32(int rho) { const int n = rho >> 4, i = rho & 15; return 8 * (i >> 2) + 4 * n + (i & 3); }

struct Unit { int pm, pn; };
struct Gemm { const bf16_t* A; const bf16_t* Bt; int M, N, K; };

struct StaticOrder {
    int nM, nN, nwg, G, c;
    __host__ __device__ void init(int M, int N, int G_, int c_) { nM = M / BM; nN = N / BM; nwg = nM * nN; G = G_; c = c_; }
    __host__ __device__ bool next(int i, Unit& u) const {
        const long L = (long)i * G + c; if (L >= nwg) return false;
        int wgid = (int)L; { const int q = nwg / NXCD, r = nwg % NXCD, xcd = wgid % NXCD, off = wgid / NXCD; wgid = (xcd < r ? xcd * (q + 1) : r * (q + 1) + (xcd - r) * q) + off; }
        const int nig = WGM * nN, gid = wgid / nig, fm = gid * WGM, gsz = (nM - fm) < WGM ? (nM - fm) : WGM;
        u.pm = fm + ((wgid % nig) % gsz); u.pn = (wgid % nig) / gsz; return true;
    }
    __device__ __forceinline__ void a_ready(const Unit&) const {}
    __device__ __forceinline__ void done(const Unit&) const {}
};

struct EpiIn {
    static constexpr bool PERM = true, AFTER_DRAIN = false; unsigned char* ws;
    __device__ __forceinline__ void operator()(const f32x4 (&acc)[2][2][4][2], const Unit& u, int wr, int wc, int fr, int fq) const {
        const int row0 = u.pm * BM + wr * 64 + fr, lcol0 = wc * 32 + 8 * fq;
#pragma unroll
        for (int ai = 0; ai < 2; ++ai)
#pragma unroll
            for (int m = 0; m < 4; ++m)
#pragma unroll
                for (int bj = 0; bj < 2; ++bj) epi_in8(ws, row0 + ai * HALF + m * 16, u.pn, bj * HALF + lcol0, acc[ai][bj][m][0], acc[ai][bj][m][1]);
    }
};
template <int WHICH> struct EpiUp {
    static constexpr bool PERM = true, AFTER_DRAIN = false; unsigned char* ws;
    __device__ __forceinline__ void operator()(const f32x4 (&acc)[2][2][4][2], const Unit& u, int wr, int wc, int fr, int fq) const {
        const int row0 = u.pm * BM + wr * 64 + fr, col0 = u.pn * BM + wc * 32 + 8 * fq;
#pragma unroll
        for (int ai = 0; ai < 2; ++ai)
#pragma unroll
            for (int m = 0; m < 4; ++m)
#pragma unroll
                for (int bj = 0; bj < 2; ++bj) {
                    if (WHICH == 1) epi_up1_8(ws, row0 + ai * HALF + m * 16, col0 + bj * HALF, acc[ai][bj][m][0], acc[ai][bj][m][1]);
                    else epi_up2_8(ws, row0 + ai * HALF + m * 16, col0 + bj * HALF, acc[ai][bj][m][0], acc[ai][bj][m][1]); }
    }
};
struct EpiOut {
    static constexpr bool PERM = false, AFTER_DRAIN = false; const float* x; float* out; float* ss;
    __device__ __forceinline__ void operator()(const f32x4 (&acc)[2][2][4][2], const Unit& u, int wr, int wc, int fr, int fq) const {
        const int row0 = u.pm * BM + wr * 64 + fr, col0 = u.pn * BM + wc * 32 + 4 * fq;
#pragma unroll
        for (int ai = 0; ai < 2; ++ai)
#pragma unroll
            for (int m = 0; m < 4; ++m) { const int row = row0 + ai * HALF + m * 16; const size_t off = (size_t)row * DM + col0; float s = 0.f;
#pragma unroll
                for (int bj = 0; bj < 2; ++bj)
#pragma unroll
                    for (int n = 0; n < 2; ++n) { const f32x4 h = *(const f32x4*)(x + off + bj * HALF + n * 16) + acc[ai][bj][m][n];
                        *(f32x4*)(out + off + bj * HALF + n * 16) = h; s += (h[0] * h[0] + h[1] * h[1]) + (h[2] * h[2] + h[3] * h[3]); }
                s += __shfl_xor(s, 16); s += __shfl_xor(s, 32);
                if (fq == 0) ss[(size_t)row * 32 + u.pn * 4 + wc] = s; }
    }
};
template <class Epi, class Sched, bool ALIGN_EPI = false, bool SP2 = false>
__device__ __forceinline__ void gemm_phase(PG8_LAS unsigned char* lds, const Gemm g, const Sched& S, const Epi& E, const int tid) {
    const int wid = __builtin_amdgcn_readfirstlane(tid >> 6), lane = tid & 63, wr = wid >> 2, wc = wid & 3, fr = lane & 15, fq = lane >> 4;
    const int K = g.K, nt = K / BK;
    unsigned voffA[2], voffB[2];
#pragma unroll
    for (int i = 0; i < 2; ++i) { int R, C; stage_rc(tid * 16 + i * 8192, R, C); const int Rb = Epi::PERM ? ((R & ~31) + perm32(R & 31)) : R;
        voffA[i] = (unsigned)(R * K + C) * 2u; voffB[i] = (unsigned)(Rb * K + C) * 2u; }
    const size_t kstep = (size_t)(BK * 2);
    const size_t hstep = (size_t)HALF * K * 2;
    const size_t tstep = 2 * hstep;
    const unsigned ldsw = (unsigned)wid * 1024u;
    const int aoff = lds_byte(wr * 64 + fr, fq * 8), boff = lds_byte(wc * 32 + fr, fq * 8);
#define PG8_SA(b, h) (((b) * 2 + (h)) * HTB)
#define PG8_SB(b, h) ((4 + (b) * 2 + (h)) * HTB)
#define PG8_STAGE(bufoff, gbase, voff) do { _Pragma("unroll") for (int _i = 0; _i < 2; ++_i) \
        __builtin_amdgcn_global_load_lds((const unsigned*)((const char*)(gbase) + (voff)[_i]), (PG8_LAS unsigned*)(lds + (bufoff) + ldsw + _i * 8192), 16, 0, 0); } while (0)
#define PG8_LDA(dst, b, h) do { _Pragma("unroll") for (int m = 0; m < 4; ++m) _Pragma("unroll") for (int k = 0; k < 2; ++k) dst[m][k] = *(const PG8_LAS bf16x8*)(lds + PG8_SA(b, h) + aoff + m * 2048 + k * 1024); } while (0)
#define PG8_LDB(dst, b, h) do { _Pragma("unroll") for (int n = 0; n < 2; ++n) _Pragma("unroll") for (int k = 0; k < 2; ++k) dst[n][k] = *(const PG8_LAS bf16x8*)(lds + PG8_SB(b, h) + boff + n * 2048 + k * 1024); } while (0)
#define PG8_MMA(ai, bj, At, Bt) do { __builtin_amdgcn_s_setprio(1); _Pragma("unroll") for (int m = 0; m < 4; ++m) _Pragma("unroll") for (int n = 0; n < 2; ++n) _Pragma("unroll") for (int k = 0; k < 2; ++k) \
        acc[ai][bj][m][n] = __builtin_amdgcn_mfma_f32_16x16x32_bf16(Bt[n][k], At[m][k], acc[ai][bj][m][n], 0, 0, 0); __builtin_amdgcn_s_setprio(0); } while (0)
#define PG8_WAIT_V(n) asm volatile("s_waitcnt vmcnt(" #n ")" ::: "memory")
#define PG8_WAIT_L(n) asm volatile("s_waitcnt lgkmcnt(" #n ")" ::: "memory")
#define PG8_BAR __builtin_amdgcn_s_barrier()
#define PG8_SCHED __builtin_amdgcn_sched_barrier(0)
    Unit cur, nxt; int ui = 0;
    if (!S.next(0, cur)) return;
    f32x4 acc[2][2][4][2];
#pragma unroll
    for (int a = 0; a < 2; ++a)
#pragma unroll
        for (int b = 0; b < 2; ++b)
#pragma unroll
            for (int m = 0; m < 4; ++m)
#pragma unroll
                for (int n = 0; n < 2; ++n) acc[a][b][m][n] = (f32x4){0.f, 0.f, 0.f, 0.f};
    bf16x8 At[4][2], B0[2][2], B1[2][2];
    const char* cA = (const char*)g.A + (size_t)cur.pm * tstep; const char* cB = (const char*)g.Bt + (size_t)cur.pn * tstep;
    S.a_ready(cur);
    if constexpr (SP2) {
        PG8_STAGE(PG8_SB(0, 0), cB, voffB); PG8_STAGE(PG8_SB(0, 1), cB + hstep, voffB); PG8_STAGE(PG8_SA(0, 0), cA, voffA); PG8_STAGE(PG8_SA(0, 1), cA + hstep, voffA);
        if (wr == 1) PG8_BAR;
        PG8_WAIT_V(2); PG8_BAR;
        PG8_STAGE(PG8_SB(1, 0), cB + kstep, voffB); PG8_STAGE(PG8_SA(1, 0), cA + kstep, voffA); PG8_STAGE(PG8_SB(1, 1), cB + hstep + kstep, voffB);
        PG8_WAIT_V(6); PG8_BAR;
    } else {
        PG8_STAGE(PG8_SB(0, 0), cB, voffB); PG8_STAGE(PG8_SA(0, 0), cA, voffA); PG8_STAGE(PG8_SB(0, 1), cB + hstep, voffB); PG8_STAGE(PG8_SA(0, 1), cA + hstep, voffA);
        if (wr == 1) PG8_BAR;
        PG8_WAIT_V(4); PG8_BAR;
        PG8_STAGE(PG8_SB(1, 0), cB + kstep, voffB); PG8_STAGE(PG8_SA(1, 0), cA + kstep, voffA); PG8_STAGE(PG8_SB(1, 1), cB + hstep + kstep, voffB);
        PG8_WAIT_V(6); PG8_BAR;
    }
    for (;;) {
        const bool has_next = S.next(ui + 1, nxt);
        const char* nA = has_next ? (const char*)g.A + (size_t)nxt.pm * tstep : cA; const char* nB = has_next ? (const char*)g.Bt + (size_t)nxt.pn * tstep : cB;
        for (int t = 0; t < nt; t += 2) {
            const bool last = (t == nt - 2);
            const char* a1 = cA + (size_t)(t + 1) * kstep;
            const char* a2 = last ? nA : cA + (size_t)(t + 2) * kstep; const char* b2 = last ? nB : cB + (size_t)(t + 2) * kstep;
            const char* a3 = a2 + kstep; const char* b3 = b2 + kstep;
            if (last && has_next) S.a_ready(nxt);
            if constexpr (SP2) {
            PG8_LDB(B0, 0, 0); PG8_LDB(B1, 0, 1); PG8_SCHED; PG8_LDA(At, 0, 0); PG8_STAGE(PG8_SA(1, 1), a1 + hstep, voffA);
            PG8_WAIT_V(8); PG8_WAIT_L(0); PG8_BAR; PG8_MMA(0, 0, At, B0); PG8_MMA(0, 1, At, B1); PG8_BAR; PG8_SCHED;
            PG8_LDA(At, 0, 1); PG8_STAGE(PG8_SB(0, 0), b2, voffB); PG8_STAGE(PG8_SB(0, 1), b2 + hstep, voffB); PG8_STAGE(PG8_SA(0, 0), a2, voffA);
            PG8_WAIT_V(8); PG8_WAIT_L(0); PG8_BAR; PG8_MMA(1, 0, At, B0); PG8_MMA(1, 1, At, B1); PG8_BAR; PG8_SCHED;
            PG8_LDB(B0, 1, 0); PG8_LDB(B1, 1, 1); PG8_SCHED; PG8_LDA(At, 1, 0); PG8_STAGE(PG8_SA(0, 1), a2 + hstep, voffA);
            PG8_WAIT_V(8); PG8_WAIT_L(0); PG8_BAR; PG8_MMA(0, 0, At, B0); PG8_MMA(0, 1, At, B1); PG8_BAR; PG8_SCHED;
            PG8_LDA(At, 1, 1); PG8_STAGE(PG8_SB(1, 0), b3, voffB); PG8_STAGE(PG8_SB(1, 1), b3 + hstep, voffB); PG8_STAGE(PG8_SA(1, 0), a3, voffA);
            PG8_WAIT_V(8); PG8_WAIT_L(0); PG8_BAR; PG8_MMA(1, 0, At, B0); PG8_MMA(1, 1, At, B1); PG8_BAR; PG8_SCHED;
            } else {
            PG8_LDB(B0, 0, 0); PG8_SCHED; PG8_LDA(At, 0, 0); PG8_STAGE(PG8_SA(1, 1), a1 + hstep, voffA);
            PG8_WAIT_L(8); PG8_BAR; PG8_WAIT_L(0); PG8_MMA(0, 0, At, B0); PG8_BAR; PG8_SCHED;
            PG8_LDB(B1, 0, 1); PG8_STAGE(PG8_SB(0, 0), b2, voffB);
            PG8_BAR; PG8_WAIT_L(0); PG8_MMA(0, 1, At, B1); PG8_BAR;
            PG8_LDA(At, 0, 1); PG8_STAGE(PG8_SA(0, 0), a2, voffA);
            PG8_BAR; PG8_WAIT_L(0); PG8_MMA(1, 0, At, B0); PG8_BAR; PG8_SCHED;
            PG8_STAGE(PG8_SB(0, 1), b2 + hstep, voffB);
            PG8_WAIT_V(6); PG8_BAR; PG8_MMA(1, 1, At, B1); PG8_BAR;
            PG8_LDB(B0, 1, 0); PG8_SCHED; PG8_LDA(At, 1, 0); PG8_STAGE(PG8_SA(0, 1), a2 + hstep, voffA);
            PG8_WAIT_L(8); PG8_BAR; PG8_WAIT_L(0); PG8_MMA(0, 0, At, B0); PG8_BAR; PG8_SCHED;
            PG8_LDB(B1, 1, 1); PG8_STAGE(PG8_SB(1, 0), b3, voffB);
            PG8_BAR; PG8_WAIT_L(0); PG8_MMA(0, 1, At, B1); PG8_BAR;
            PG8_LDA(At, 1, 1); PG8_STAGE(PG8_SA(1, 0), a3, voffA);
            PG8_BAR; PG8_WAIT_L(0); PG8_MMA(1, 0, At, B0); PG8_BAR; PG8_SCHED;
            PG8_STAGE(PG8_SB(1, 1), b3 + hstep, voffB);
            PG8_WAIT_V(6); PG8_BAR; PG8_MMA(1, 1, At, B1); PG8_BAR;
            }
        }
        if constexpr (ALIGN_EPI) { if (wr == 0) PG8_BAR; }
        if constexpr (!Epi::AFTER_DRAIN) { E(acc, cur, wr, wc, fr, fq); S.done(cur); }
        if (!has_next) break;
#pragma unroll
        for (int a = 0; a < 2; ++a)
#pragma unroll
            for (int b = 0; b < 2; ++b)
#pragma unroll
                for (int m = 0; m < 4; ++m)
#pragma unroll
                    for (int n = 0; n < 2; ++n) acc[a][b][m][n] = (f32x4){0.f, 0.f, 0.f, 0.f};
        cur = nxt; cA = nA; cB = nB; ++ui;
        if constexpr (ALIGN_EPI) { if (wr == 1) PG8_BAR; }
    }
    PG8_WAIT_V(0);
    if constexpr (!ALIGN_EPI) { if (wr == 0) PG8_BAR; }
    PG8_BAR;
    if constexpr (Epi::AFTER_DRAIN) { E.fused(acc, cur, wr, wc, fr, fq, lds, wid, lane); S.done(cur); }
#undef PG8_SA
#undef PG8_SB
#undef PG8_STAGE
#undef PG8_LDA
#undef PG8_LDB
#undef PG8_MMA
#undef PG8_WAIT_V
#undef PG8_WAIT_L
#undef PG8_BAR
#undef PG8_SCHED
}
}

namespace att {
constexpr int D = 128, LD = 2048;
constexpr float THR = 8.f; constexpr bool WSKIP = false;
constexpr float SCALE = 0.08838834764831845f;
constexpr int NW = 8, QBLK = 32, KVBLK = 64, QB = NW * QBLK;
constexpr int SHM_V = KVBLK * D * 2, SHM_K = KVBLK * D * 2;
constexpr int ATT_LDS_BYTES = 2 * SHM_V + 2 * SHM_K + NW * 64 * 4;
using bf16 = __hip_bfloat16;
typedef short s16x4 __attribute__((ext_vector_type(4)));
typedef float f32x16 __attribute__((ext_vector_type(16)));
template <class A, class Bt> struct same_t { static constexpr bool v = false; };
template <class A> struct same_t<A, A> { static constexpr bool v = true; };

#define KSWZ(row, colB) ((row) * 256 + ((colB) ^ (((row) & 7) << 4)))
#define SBAR() __builtin_amdgcn_sched_barrier(0)
__device__ __forceinline__ int v_st(int k, int c) { const int kk = (k & ~0xC) | ((k & 4) << 1) | ((k & 8) >> 1); return ((kk >> 3) * 4 + (c >> 5)) * 512 + ((kk & 7) * 32 + (c & 31)) * 2; }
__device__ __forceinline__ int v_rd_base(int lane) { return ((lane & 3) << 3) | (((lane >> 2) & 3) << 6) | (((lane >> 4) & 1) << 5) | (((lane >> 5) & 1) << 8); }
constexpr int v_rd_off(int d0, int ks, int half) { return d0 * 512 + ks * 4096 + half * 2048; }
__device__ __forceinline__ int crow(int r, int hi) { return (r & 3) + 8 * (r >> 2) + 4 * hi; }
__device__ __forceinline__ unsigned cvtpk(float lo, float hi) {
    unsigned r; asm volatile("v_cvt_pk_bf16_f32 %0, %1, %2" : "=v"(r) : "v"(lo), "v"(hi)); return r;
}
__device__ __forceinline__ bf16x8 pack8(f32x4 a, f32x4 b) {
    u32x4 w = {cvtpk(a[0], a[1]), cvtpk(a[2], a[3]), cvtpk(b[0], b[1]), cvtpk(b[2], b[3])};
    return *reinterpret_cast<bf16x8*>(&w);
}
template <class T> __device__ __forceinline__ bf16x8 load8(const T* p) {
    if constexpr (same_t<T, float>::v) { return pack8(*(const f32x4*)p, *(const f32x4*)(p + 4)); }
    else { return *reinterpret_cast<const bf16x8*>(p); }
}
__device__ __forceinline__ void mask_tile(const bool LIN, f32x16& p0, f32x16& p1, int dq, unsigned W) {
    const float NEG = LIN ? 0.f : -__builtin_inff();
#pragma unroll
    for (int r = 0; r < 16; ++r) {
        const int c = (r & 3) + 8 * (r >> 2);
        if ((unsigned)(dq - c) >= W) p0[r] = NEG;
        if ((unsigned)(dq - c - 32) >= W) p1[r] = NEG;
    }
}
__device__ __forceinline__ void partialSM(const bool LIN, f32x16& p0, f32x16& p1, float& m_reg, float& mn, float& alpha) {
    if (LIN) { alpha = 1.f; mn = 0.f; return; }
    float pmax = p0[0]; for (int r = 1; r < 16; ++r) pmax = fmaxf(pmax, p0[r]); for (int r = 0; r < 16; ++r) pmax = fmaxf(pmax, p1[r]);
    { auto rr = __builtin_amdgcn_permlane32_swap(__float_as_uint(pmax), __float_as_uint(pmax), false, false);
      pmax = fmaxf(__uint_as_float(rr[0]), __uint_as_float(rr[1])); }
    constexpr float C2 = 1.4426950408889634f * SCALE;
    if (__builtin_expect(__all((pmax - m_reg) * SCALE <= THR), 1)) { mn = m_reg; alpha = 1.f; }
    else { mn = fmaxf(m_reg, pmax); alpha = __builtin_amdgcn_exp2f((m_reg - mn) * C2); m_reg = mn; }
    const float mnL = -mn * C2;
    for (int r = 0; r < 16; ++r) p0[r] = fmaf(p0[r], C2, mnL); for (int r = 0; r < 16; ++r) p1[r] = fmaf(p1[r], C2, mnL);
    for (int r = 0; r < 16; ++r) p0[r] = __builtin_amdgcn_exp2f(p0[r]);
}
__device__ __forceinline__ void finishSM(const bool LIN, f32x16& p0, f32x16& p1, float alpha, float& l_reg, bf16x8& pa0, bf16x8& pa1, bf16x8& pa2, bf16x8& pa3) {
    if (!LIN) {
    for (int r = 0; r < 16; ++r) p1[r] = __builtin_amdgcn_exp2f(p1[r]);
    float ps = 0; for (int r = 0; r < 16; ++r) ps += p0[r]; for (int r = 0; r < 16; ++r) ps += p1[r];
    { auto rr = __builtin_amdgcn_permlane32_swap(__float_as_uint(ps), __float_as_uint(ps), false, false);
      ps = __uint_as_float(rr[0]) + __uint_as_float(rr[1]); }
    l_reg = l_reg * alpha + ps;
    }
#define PK4(P, B_, OUT) do { unsigned a0 = cvtpk(P[B_+0], P[B_+1]), a1 = cvtpk(P[B_+2], P[B_+3]);                          \
        unsigned b0 = cvtpk(P[B_+4], P[B_+5]), b1 = cvtpk(P[B_+6], P[B_+7]);                                             \
        auto r0 = __builtin_amdgcn_permlane32_swap(a0, b0, false, false); auto r1 = __builtin_amdgcn_permlane32_swap(a1, b1, false, false); \
        u32x4 w = {r0[0], r1[0], r0[1], r1[1]}; OUT = *reinterpret_cast<bf16x8*>(&w); } while (0)
    PK4(p0, 0, pa0); PK4(p0, 8, pa1); PK4(p1, 0, pa2); PK4(p1, 8, pa3);
#undef PK4
}
template <int KB, bool SK>
__device__ __forceinline__ void qkt(f32x16& p0, f32x16& p1, const char* K_lds, int r32, int hi, const bf16x8* qr, bool act) {
    if (SK && !act) { const float NEG = -__builtin_inff();
#pragma unroll
        for (int r = 0; r < 16; ++r) { p0[r] = NEG; p1[r] = NEG; } return; }
    p0 = f32x16{}; p1 = f32x16{};
    const char* kb[4];
#pragma unroll
    for (int dd = 0; dd < 4; ++dd) kb[dd] = K_lds + KB * SHM_K + KSWZ(r32, (dd * 16 + hi * 8) * 2);
#pragma unroll
    for (int d0 = 0; d0 < 8; ++d0) { const char* a = kb[d0 & 3] + (d0 >> 2) * 128;
        bf16x8 b0 = *reinterpret_cast<const bf16x8*>(a);
        bf16x8 b1 = *reinterpret_cast<const bf16x8*>(a + 32 * 256);
        p0 = __builtin_amdgcn_mfma_f32_32x32x16_bf16(b0, qr[d0], p0, 0, 0, 0);
        p1 = __builtin_amdgcn_mfma_f32_32x32x16_bf16(b1, qr[d0], p1, 0, 0, 0); }
}
template <int VB, bool SK>
__device__ __forceinline__ void pv_tile(f32x16* o, int vb0, bf16x8 pa0, bf16x8 pa1, bf16x8 pa2, bf16x8 pa3, bool act) {
    if (SK && !act) return;
#define TRRD(dst, off) asm volatile("ds_read_b64_tr_b16 %0, %1 offset:%2" : "=&v"(dst) : "v"(vb0), "i"(off) : "memory")
#define PV_D0(d0) do { s16x4 l0, l1, l2, l3, h0, h1, h2, h3; constexpr int b_ = VB * SHM_V + v_rd_off(d0, 0, 0);     \
        TRRD(l0, b_); TRRD(h0, b_ + 2048); TRRD(l1, b_ + 4096); TRRD(h1, b_ + 6144); TRRD(l2, b_ + 8192); TRRD(h2, b_ + 10240); TRRD(l3, b_ + 12288); TRRD(h3, b_ + 14336); \
        asm volatile("s_waitcnt lgkmcnt(0)" ::: "memory"); SBAR();                 \
        o[d0] = __builtin_amdgcn_mfma_f32_32x32x16_bf16(pa0, (bf16x8){l0[0], l0[1], l0[2], l0[3], h0[0], h0[1], h0[2], h0[3]}, o[d0], 0, 0, 0);   \
        o[d0] = __builtin_amdgcn_mfma_f32_32x32x16_bf16(pa1, (bf16x8){l1[0], l1[1], l1[2], l1[3], h1[0], h1[1], h1[2], h1[3]}, o[d0], 0, 0, 0);   \
        o[d0] = __builtin_amdgcn_mfma_f32_32x32x16_bf16(pa2, (bf16x8){l2[0], l2[1], l2[2], l2[3], h2[0], h2[1], h2[2], h2[3]}, o[d0], 0, 0, 0);   \
        o[d0] = __builtin_amdgcn_mfma_f32_32x32x16_bf16(pa3, (bf16x8){l3[0], l3[1], l3[2], l3[3], h3[0], h3[1], h3[2], h3[3]}, o[d0], 0, 0, 0); } while (0)
    PV_D0(0); PV_D0(1); PV_D0(2); PV_D0(3);
#undef PV_D0
#undef TRRD
}

template <class TIn, class TOut> struct BlockRef { const TIn* Q; const TIn* K; const TIn* V; TOut* O; int P0; };
template <class TIn> struct Seam {
    bf16x8 qr[8];
    bf16x8 st_v0, st_v1, st_k0, st_k1; f32x4 sf0, sf1, sf2, sf3;
    f32x4 tq[16];
};
__device__ __forceinline__ int swa_jlo(int P0, int W) { const int lowk = P0 - W + 1; return lowk > 0 ? lowk / KVBLK : 0; }
#define ROW(p, k0, rr) ((p) + (unsigned)(((k0) + (rr)) * LD + sc))
#define VMW() asm volatile("s_waitcnt vmcnt(0)" ::: "memory")
#define VMWN(n) asm volatile("s_waitcnt vmcnt(%0)" :: "i"(n) : "memory")
#define SLOAD_H(Kp, Vp, k0) do { S.st_v0 = load8<TIn>(ROW(Vp, k0, sr)); S.st_v1 = load8<TIn>(ROW(Vp, k0, 32 + sr));              \
                         S.st_k0 = load8<TIn>(ROW(Kp, k0, sr)); S.st_k1 = load8<TIn>(ROW(Kp, k0, 32 + sr)); } while (0)
#define SWRITE_HK(bf) do { *(bf16x8*)(K_lds + (bf) * SHM_K + kws) = S.st_k0; *(bf16x8*)(K_lds + (bf) * SHM_K + kws + 32 * 256) = S.st_k1; } while (0)
#define SWRITE_HV(bf) do { *(bf16x8*)(V_lds + (bf) * SHM_V + vst0) = S.st_v0; *(bf16x8*)(V_lds + (bf) * SHM_V + vst1) = S.st_v1; } while (0)
#define SWRITE_H(bf) do { SWRITE_HV(bf); SWRITE_HK(bf); } while (0)
#define SLOAD_F(p, k0) do { S.sf0 = *(const f32x4*)ROW(p, k0, sr); S.sf1 = *(const f32x4*)(ROW(p, k0, sr) + 4);                \
                            S.sf2 = *(const f32x4*)ROW(p, k0, 32 + sr); S.sf3 = *(const f32x4*)(ROW(p, k0, 32 + sr) + 4); } while (0)
#define SWRITE_KF(bf) do { *(bf16x8*)(K_lds + (bf) * SHM_K + kws) = pack8(S.sf0, S.sf1); *(bf16x8*)(K_lds + (bf) * SHM_K + kws + 32 * 256) = pack8(S.sf2, S.sf3); } while (0)
#define SWRITE_VF(bf) do { *(bf16x8*)(V_lds + (bf) * SHM_V + vst0) = pack8(S.sf0, S.sf1); *(bf16x8*)(V_lds + (bf) * SHM_V + vst1) = pack8(S.sf2, S.sf3); } while (0)
template <class TIn, class TOut>
__device__ __forceinline__ void causal_swa_prime(const BlockRef<TIn, TOut>& cur, int W, char* lds, Seam<TIn>& S, const int tid) {
    constexpr bool F32 = same_t<TIn, float>::v;
    const int wid = __builtin_amdgcn_readfirstlane(tid >> 6), lane = tid & 63, r32 = lane & 31, hi = lane >> 5;
    const int sr = tid >> 4, sc = (tid & 15) * 8, kws = KSWZ(sr, sc * 2); char* K_lds = lds + 2 * SHM_V;
    const int kb0 = swa_jlo(cur.P0, W) * KVBLK;
    for (int d0 = 0; d0 < 8; ++d0) S.qr[d0] = load8<TIn>(cur.Q + (unsigned)((wid * QBLK + r32) * LD + d0 * 16 + hi * 8));
    if constexpr (F32) { SLOAD_F((const float*)cur.K, kb0); VMW(); SWRITE_KF(0); SBAR(); SLOAD_F((const float*)cur.V, kb0); }
    else { SLOAD_H(cur.K, cur.V, kb0); VMW(); SWRITE_HK(0); }
    __syncthreads();
}
template <class TIn, class TOut>
__device__ __forceinline__ void causal_swa_block(const bool LIN, const BlockRef<TIn, TOut>& cur, const BlockRef<TIn, TOut>& nxt, int skv, int W, char* lds, Seam<TIn>& S, const int tid) {
    constexpr bool F32 = same_t<TIn, float>::v;
    const int wid = __builtin_amdgcn_readfirstlane(tid >> 6), lane = tid & 63, r32 = lane & 31, hi = lane >> 5;
    const int j_lo = swa_jlo(cur.P0, W);
    int j_hi = (cur.P0 + QB - 1) / KVBLK + 1; if (j_hi > skv / KVBLK) j_hi = skv / KVBLK;
    const int NT = j_hi - j_lo;
    const int kbn = swa_jlo(nxt.P0, W) * KVBLK;
    const int qlo = cur.P0 + wid * QBLK, qm = qlo + r32 - 4 * hi;
    char* V_lds = lds; char* K_lds = lds + 2 * SHM_V;
    float* ws = (float*)(lds + 2 * SHM_V + 2 * SHM_K) + wid * 64; float* li_l = ws, * al_l = ws + 32;
    float m_reg = -1e30f, l_reg = 0; f32x16 o[4] = {};
    const int sr = tid >> 4, sc = (tid & 15) * 8, vst0 = v_st(sr, sc), vst1 = v_st(32 + sr, sc), kws = KSWZ(sr, sc * 2);
    const int vb0 = (int)(uintptr_t)V_lds + v_rd_base(lane);
    const TIn* Kh = cur.K; const TIn* Vh = cur.V;
#define RESC(a) do { if (!LIN && __any((a) < 1.f)) { if (hi == 0) al_l[r32] = (a); asm volatile("s_waitcnt lgkmcnt(0)" ::: "memory");              \
                     for (int d_ = 0; d_ < 4; ++d_) for (int r = 0; r < 16; ++r) o[d_][r] *= al_l[crow(r, hi)]; } } while (0)
#define KBASE(t) ((j_lo + (t)) * KVBLK)
#define ACT(t) (KBASE(t) <= qlo + QBLK - 1 && KBASE(t) + KVBLK - 1 >= qlo - W + 1)
#define MASKT(P0_, P1_, t) do { const int kb_ = KBASE(t); if ((!SK || ACT(t)) && (kb_ + KVBLK - 1 > qlo || kb_ <= qlo + QBLK - 1 - W)) mask_tile(LIN, P0_, P1_, qm - kb_, (unsigned)W); } while (0)
    constexpr int NQL = F32 ? 16 : 8;
    constexpr bool SK = WSKIP && !F32;
#define SEAM_K0() do { VMWN(NQL); if constexpr (F32) { SWRITE_KF(0); SBAR(); SLOAD_F((const float*)nxt.V, kbn); } else { SWRITE_HK(0); } SBAR(); } while (0)
    f32x16 pA0, pA1, pB0, pB1; float mnA, mnB, alA, alB; bf16x8 pa0, pa1, pa2, pa3;
    if constexpr (F32) { VMW(); SWRITE_VF(0); SBAR(); } else { SWRITE_HV(0); SBAR(); }
    if (NT > 1) { if constexpr (F32) SLOAD_F((const float*)Kh, KBASE(1)); else SLOAD_H(Kh, Vh, KBASE(1)); }
    SBAR(); qkt<0, SK>(pA0, pA1, K_lds, r32, hi, S.qr, ACT(0));
    if constexpr (F32) { if (NT > 1) { VMW(); SWRITE_KF(1); SBAR(); SLOAD_F((const float*)Vh, KBASE(1)); } }
    MASKT(pA0, pA1, 0); partialSM(LIN, pA0, pA1, m_reg, mnA, alA);
    if (NT > 1) { VMW(); if constexpr (F32) { SWRITE_VF(1); SBAR(); if (NT > 2) SLOAD_F((const float*)Kh, KBASE(2)); } else SWRITE_H(1); }
    __syncthreads();
#define HALF_STEP(PX0, PX1, mnX, alX, PY0, PY1, alY, t, KB, VB, SB) do {                                                      \
        SBAR(); qkt<KB, SK>(PX0, PX1, K_lds, r32, hi, S.qr, ACT(t));                                             \
        finishSM(LIN, PY0, PY1, alY, l_reg, pa0, pa1, pa2, pa3); SBAR();                                                           \
        if ((t) + 1 < NT) { if constexpr (F32) { VMW(); SWRITE_KF(SB); SBAR(); SLOAD_F((const float*)Vh, KBASE((t) + 1)); }  \
                            else { SLOAD_H(Kh, Vh, KBASE((t) + 1)); } SBAR(); }                                               \
        pv_tile<VB, SK>(o, vb0, pa0, pa1, pa2, pa3, ACT((t) - 1)); MASKT(PX0, PX1, (t)); partialSM(LIN, PX0, PX1, m_reg, mnX, alX);                                        \
        __syncthreads();                                                                                                      \
        if ((t) + 1 < NT) { VMW(); if constexpr (F32) { SWRITE_VF(SB); SBAR(); if ((t) + 2 < NT) SLOAD_F((const float*)Kh, KBASE((t) + 2)); } \
                            else { SWRITE_H(SB); } }                                                                          \
        RESC(alX); __syncthreads(); } while (0)
    for (int t = 1; t + 1 < NT; t += 2) {
        HALF_STEP(pB0, pB1, mnB, alB, pA0, pA1, alA, t, 1, 0, 0);
        HALF_STEP(pA0, pA1, mnA, alA, pB0, pB1, alB, t + 1, 0, 1, 1);
    }
    const bool even = (NT & 1) == 0;
    if (even) { SBAR(); qkt<1, SK>(pB0, pB1, K_lds, r32, hi, S.qr, ACT(NT - 1)); SBAR(); }
#define QROW(e) (nxt.Q + (size_t)(wid * QBLK + r32) * LD + ((e) >> 1) * 16 + hi * 8 + ((e) & 1) * 4)
    if constexpr (F32) { SLOAD_F((const float*)nxt.K, kbn); SBAR();
#pragma unroll
        for (int e = 0; e < 8; ++e) S.tq[e] = *(const f32x4*)QROW(e); }
    else { SLOAD_H(nxt.K, nxt.V, kbn); SBAR();
#pragma unroll
        for (int d0 = 0; d0 < 8; ++d0) S.qr[d0] = load8<TIn>(nxt.Q + (unsigned)((wid * QBLK + r32) * LD + d0 * 16 + hi * 8)); }
    SBAR();
    finishSM(LIN, pA0, pA1, alA, l_reg, pa0, pa1, pa2, pa3); SBAR();
    if constexpr (F32) {
#pragma unroll
        for (int e = 8; e < 16; ++e) S.tq[e] = *(const f32x4*)QROW(e); SBAR(); }
#undef QROW
    pv_tile<0, SK>(o, vb0, pa0, pa1, pa2, pa3, ACT(even ? NT - 2 : NT - 1));
    if (even) { MASKT(pB0, pB1, NT - 1); partialSM(LIN, pB0, pB1, m_reg, mnB, alB); __syncthreads(); RESC(alB);
        finishSM(LIN, pB0, pB1, alB, l_reg, pa0, pa1, pa2, pa3); SBAR(); pv_tile<1, SK>(o, vb0, pa0, pa1, pa2, pa3, ACT(NT - 1)); }
    SBAR(); SEAM_K0();
    if (hi == 0) li_l[r32] = l_reg; asm volatile("s_waitcnt lgkmcnt(0)" ::: "memory");
    float rli[16];
#pragma unroll
    for (int r = 0; r < 16; ++r) rli[r] = LIN ? 1.f : __builtin_amdgcn_rcpf(li_l[crow(r, hi)]);
    TOut* Ow = cur.O + (size_t)(wid * QBLK) * LD;
#pragma unroll
    for (int r = 0; r < 16; ++r) { const int orow = crow(r, hi);
#pragma unroll
        for (int d0 = 0; d0 < 4; ++d0) { const float v = o[d0][r] * rli[r];
            if constexpr (same_t<TOut, float>::v) { Ow[(size_t)orow * LD + d0 * 32 + r32] = v; }
            else { const float vn = __shfl_xor(v, 1);
                   if ((r32 & 1) == 0) *(unsigned*)(Ow + (size_t)orow * LD + d0 * 32 + r32) = cvtpk(v, vn); } } }
    if constexpr (F32) {
#pragma unroll
        for (int d0 = 0; d0 < 8; ++d0) S.qr[d0] = pack8(S.tq[2 * d0], S.tq[2 * d0 + 1]); }
    __syncthreads();
#undef RESC
#undef KBASE
#undef ACT
#undef MASKT
#undef SEAM_K0
#undef HALF_STEP
}
#undef ROW
#undef VMW
#undef VMWN
#undef SLOAD_H
#undef SWRITE_HK
#undef SWRITE_HV
#undef SWRITE_H
#undef SLOAD_F
#undef SWRITE_KF
#undef SWRITE_VF

#undef KSWZ
#undef SBAR
}
constexpr int NWAVES = 8;
constexpr int LDS_BYTES = 147456;
constexpr int MISC_OFF = 131072;
constexpr size_t WS_BAR = 65536;
static_assert(pg8::STAGE_BYTES <= LDS_BYTES && att::ATT_LDS_BYTES <= LDS_BYTES, "LDS map");

__device__ __forceinline__ int fresh_lane() { int l; asm volatile("v_mbcnt_lo_u32_b32 %0, -1, 0\n\tv_mbcnt_hi_u32_b32 %0, -1, %0" : "=v"(l)); return l; }
typedef att::BlockRef<att::bf16, att::bf16> ABlock;
__device__ __forceinline__ ABlock attn_ref(unsigned char* ws, int vcu, int G, int nd, int s, bool& lin) {
    const int it = s >> 1, pass = s & 1; ABlock r;
    if (it < nd) {
        const int id = vcu + it * G, x = id & 3, vh = (id >> 2) & 1, hc = (id >> 3) & 15, b = id >> 7, qb = pass ? 7 - x : x;
        const size_t rb = (size_t)b * SEQ * 2048, rq = rb + (size_t)qb * 256 * 2048;
        r.Q = (const att::bf16*)(ws + WS_DQ) + rq + hc * 128; r.K = (const att::bf16*)(ws + WS_DK) + rb + hc * 128;
        r.V = (const att::bf16*)(ws + WS_DV) + rb + (hc >> 1) * 256 + vh * 128;
        r.O = (att::bf16*)(ws + ((hc & 1) ? WS_O2 : WS_O1)) + rq + (hc >> 1) * 256 + vh * 128; r.P0 = qb * 256; lin = false;
    } else {
        const int id = vcu + (it - nd) * G, x = id & 3, vh = (id >> 2) & 1, h = (id >> 3) & 7, b = id >> 6, qb = pass ? 7 - x : x;
        const size_t rb = (size_t)b * SEQ * 2048, rq = rb + (size_t)qb * 256 * 2048;
        r.Q = (const att::bf16*)(ws + WS_RQK) + rq + h * 128; r.K = (const att::bf16*)(ws + WS_RQK) + rb + 1024 + h * 128;
        r.V = (const att::bf16*)(ws + WS_RV) + rb + h * 256 + vh * 128;
        r.O = (att::bf16*)(ws + WS_ORET) + rq + h * 256 + vh * 128; r.P0 = qb * 256; lin = true;
    }
    return r;
}
__device__ __forceinline__ void attn_phase(unsigned char* ws, char* lds, int vcu, int G, const int wave) {
    const int nd = vcu < 512 ? (512 - vcu + G - 1) / G : 0, nr = vcu < 256 ? (256 - vcu + G - 1) / G : 0, total = 2 * (nd + nr);
    if (total == 0) return;
    bool lin_cur, lin_nxt;
    ABlock cur = attn_ref(ws, vcu, G, nd, 0, lin_cur);
    att::Seam<att::bf16> S;
    att::causal_swa_prime<att::bf16, att::bf16>(cur, SEQ, lds, S, wave * 64 + fresh_lane());
    for (int s = 0; s < total; ++s) {
        ABlock nxt = cur; lin_nxt = lin_cur; if (s + 1 < total) nxt = attn_ref(ws, vcu, G, nd, s + 1, lin_nxt);
        att::causal_swa_block<att::bf16, att::bf16>(lin_cur, cur, nxt, SEQ, SEQ, lds, S, wave * 64 + fresh_lane()); cur = nxt; lin_cur = lin_nxt;
    }
}


typedef unsigned v4u __attribute__((ext_vector_type(4)));
#define XB_TMO      128
#define XB_XCNT(j)  (256  + 64 * (j))
#define XB_XSUB(j)  (1280 + 64 * (j))
#define XB_XGEN(j)  (2304 + 64 * (j))
#define XB_TOP      3328
#define XB_TOPGEN   3392
#define XCD_BAR_WORDS 3456
#define XB_SPIN_CAP (1u << 18)

__device__ __forceinline__ unsigned xb_ld(unsigned* p)              { return __hip_atomic_load(p, __ATOMIC_RELAXED, __HIP_MEMORY_SCOPE_AGENT); }
__device__ __forceinline__ unsigned xb_add(unsigned* p, unsigned v) { return __hip_atomic_fetch_add(p, v, __ATOMIC_RELAXED, __HIP_MEMORY_SCOPE_AGENT); }
__device__ __forceinline__ unsigned xb_xcc_id() { return (unsigned)__builtin_amdgcn_s_getreg((3 << 11) | 20) & 0xFu; }
#define XB_SPIN(cond, bar) do { unsigned _sp = 0; while (cond) { __builtin_amdgcn_s_sleep(1); \
    if ((++_sp & 255u) == 0u) { if (xb_ld(&(bar)[XB_TMO])) break; if (_sp > XB_SPIN_CAP) { atomicAdd(&(bar)[XB_TMO], 1u); break; } } } } while (0)

struct XcdBarrier {
    unsigned* bar; unsigned x;
    volatile LAS unsigned* st;
};

__device__ __forceinline__ XcdBarrier xcd_barrier_post(unsigned* bar, volatile LAS unsigned* st, int tid) {
    XcdBarrier b; b.bar = bar; b.x = xb_xcc_id(); b.st = st;
    if (tid == 0) (void)xb_add(&bar[XB_XCNT(b.x)], 1u);
    return b;
}
__device__ __forceinline__ void xcd_barrier_complete(unsigned* bar, unsigned x, unsigned& nloc, unsigned& nx) {
    const unsigned G = gridDim.x * gridDim.y * gridDim.z;
    unsigned sum, cnt, mine, sp = 0u;
    for (;;) {
        sum = 0u; cnt = 0u; mine = 0u;
#pragma unroll
        for (unsigned j = 0; j < 16; ++j) { const unsigned c = xb_ld(&bar[XB_XCNT(j)]); sum += c; cnt += (c > 0u) ? 1u : 0u; mine = (j == x) ? c : mine; }
        if (sum == G) break;
        __builtin_amdgcn_s_sleep(1);
        if ((++sp & 255u) == 0u) { if (xb_ld(&bar[XB_TMO])) break; if (sp > XB_SPIN_CAP) { atomicAdd(&bar[XB_TMO], 1u); break; } }
    }
    nloc = mine > 0u ? mine : 1u; nx = cnt > 0u ? cnt : 1u;
}

__device__ __forceinline__ void xcd_barrier(const XcdBarrier& b, int tid) {
    asm volatile("s_waitcnt vmcnt(0)" ::: "memory");
    __syncthreads();
    if (tid == 0) {
        unsigned* bar = b.bar;
        __builtin_amdgcn_s_waitcnt(0);
        unsigned nloc = b.st[0], nx = b.st[1];
        if (nloc == 0u) { xcd_barrier_complete(bar, b.x, nloc, nx); b.st[0] = nloc; b.st[1] = nx; }
        const unsigned old = xb_add(&bar[XB_XSUB(b.x)], 1u);
        const unsigned gen = old / nloc;
        if (old + 1u == (gen + 1u) * nloc) {
            __builtin_amdgcn_fence(__ATOMIC_RELEASE, "agent");
            asm volatile("s_waitcnt vmcnt(0)" ::: "memory");
            const unsigned og = xb_add(&bar[XB_TOP], 1u);
            const unsigned tg = og / nx;
            if (og + 1u == (tg + 1u) * nx) xb_add(&bar[XB_TOPGEN], 1u);
            else XB_SPIN(xb_ld(&bar[XB_TOPGEN]) == tg, bar);
            __builtin_amdgcn_fence(__ATOMIC_ACQUIRE, "agent");
            xb_add(&bar[XB_XGEN(b.x)], 1u);
            asm volatile("s_waitcnt vmcnt(0)" ::: "memory");
        } else {
            XB_SPIN(xb_ld(&bar[XB_XGEN(b.x)]) == gen, bar);
            __builtin_amdgcn_fence(__ATOMIC_ACQUIRE, "agent");
            asm volatile("s_waitcnt vmcnt(0)" ::: "memory");
        }
    }
    __syncthreads();
}


#ifndef PG8_SP2
#define PG8_SP2 true
#endif
#ifndef PG8_ALIGN
#define PG8_ALIGN true
#endif
#ifndef PHASE_MASK
#define PHASE_MASK 0x7f
#endif
#ifndef REPEAT
#define REPEAT 0
#endif
constexpr int N_PHASES = 7;
__global__ void __launch_bounds__(NWAVES * 64, 2) k_mega(Ptrs P, int ph_lo, int ph_hi) {
    extern __shared__ __attribute__((aligned(16))) unsigned char lds[];
    LAS unsigned char* lds3 = (LAS unsigned char*)lds;
    const int wave = __builtin_amdgcn_readfirstlane((int)threadIdx.x >> 6);
    const int G = gridDim.x, bx = blockIdx.x, vcu = (G % 8 == 0) ? (bx % 8) * (G / 8) + bx / 8 : bx;
    const int gw = vcu * NWAVES + wave, NGW = G * NWAVES;
    unsigned char* ws = P.ws;
#define TID() (wave * 64 + fresh_lane())
    volatile LAS unsigned* MISC = (volatile LAS unsigned*)(lds3 + MISC_OFF);
    { const int t0 = TID(); if (t0 < 32) MISC[t0] = 0u; }
    __syncthreads();
    const bool multi = ph_hi - ph_lo > 1;
    XcdBarrier bar; bar.bar = (unsigned*)(ws + WS_BAR); bar.x = 0; bar.st = MISC + 8;
#if !(defined(USE_CG) && USE_CG)
    if (multi) bar = xcd_barrier_post((unsigned*)(ws + WS_BAR), MISC + 8, TID());
#endif
#define IN(k) (((PHASE_MASK >> (k)) & 1) && ph_lo <= (k) && (k) < ph_hi)
#if defined(USE_CG) && USE_CG
#define SEAM(k) do { if (IN(k) && IN((k) + 1)) cg::this_grid().sync(); } while (0)
#else
#define SEAM(k) do { if (IN(k) && IN((k) + 1)) xcd_barrier(bar, TID()); } while (0)
#endif
#define REP(k) for (int rep_ = 0; rep_ <= ((REPEAT >> (k)) & 1); ++rep_, (((REPEAT >> (k)) & 1) && rep_ == 1) ? xcd_barrier(bar, TID()) : (void)0)
    if (IN(0)) REP(0) p0_prologue(P, (LAS float*)(lds3 + wave * 16384), gw, NGW, fresh_lane());
    SEAM(0);
    if (IN(1)) REP(1) { pg8::Gemm g{(const bf16_t*)(ws + WS_XN), (const bf16_t*)(ws + WS_WINT), M, NIN, DM}; pg8::StaticOrder S; S.init(M, NIN, G, bx);
        pg8::EpiIn E{ws}; pg8::gemm_phase<pg8::EpiIn, pg8::StaticOrder, PG8_ALIGN, PG8_SP2>(lds3, g, S, E, TID()); }
    SEAM(1);
    if (IN(2)) REP(2) attn_phase(ws, (char*)lds, vcu, G, wave);
    SEAM(2);
    if (IN(3)) REP(3) post_rows(P, gw, NGW, fresh_lane());
    SEAM(3);
    if (IN(4)) REP(4) {
        { pg8::Gemm g{(const bf16_t*)(ws + WS_AR), (const bf16_t*)(ws + WS_WRUT), M, DM, DM}; pg8::StaticOrder S; S.init(M, DM, G, bx);
          pg8::EpiUp<1> E{ws}; pg8::gemm_phase<pg8::EpiUp<1>, pg8::StaticOrder, PG8_ALIGN, PG8_SP2>(lds3, g, S, E, TID()); }
        { pg8::Gemm g{(const bf16_t*)(ws + WS_AD), (const bf16_t*)(ws + WS_WDUT), M, DM, DM}; pg8::StaticOrder S; S.init(M, DM, G, bx);
          pg8::EpiUp<2> E{ws}; pg8::gemm_phase<pg8::EpiUp<2>, pg8::StaticOrder, PG8_ALIGN, PG8_SP2>(lds3, g, S, E, TID()); }
    }
    SEAM(4);
    if (IN(5)) REP(5) { pg8::Gemm g{(const bf16_t*)(ws + WS_MIX), (const bf16_t*)(ws + WS_WOUTT), M, DM, DM}; pg8::StaticOrder S; S.init(M, DM, G, bx);
        pg8::EpiOut E{P.x, P.out, (float*)(ws + WS_SS)}; pg8::gemm_phase<pg8::EpiOut, pg8::StaticOrder, PG8_ALIGN, PG8_SP2>(lds3, g, S, E, TID()); }
    SEAM(5);
    if (IN(6)) final_rows(P, gw, NGW, fresh_lane());
#undef IN
#undef SEAM
#undef REP
#undef TID
}
static void opt_launch(const Ptrs& P, hipStream_t stream) {
    static int grid = 0;
    if (grid == 0) {
        int dev = 0, cus = 0, per_cu = 0;
        (void)hipGetDevice(&dev); (void)hipDeviceGetAttribute(&cus, hipDeviceAttributeMultiprocessorCount, dev);
        if (hipFuncSetAttribute((const void*)k_mega, hipFuncAttributeMaxDynamicSharedMemorySize, LDS_BYTES) != hipSuccess) { fprintf(stderr, "hipFuncSetAttribute failed\n"); grid = -1; return; }
        if (hipOccupancyMaxActiveBlocksPerMultiprocessor(&per_cu, (const void*)k_mega, NWAVES * 64, LDS_BYTES) != hipSuccess || per_cu < 1) { fprintf(stderr, "occupancy query: %d blocks per CU\n", per_cu); grid = -1; return; }
        grid = cus;
        fprintf(stderr, "k_mega: grid %d (cus %d, per_cu %d)\n", grid, cus, per_cu);
    }
    if (grid < 0) return;
#if MODE == 2
    (void)hipMemsetAsync(P.ws + WS_BAR, 0, 16384, stream);
    Ptrs p = P; int lo = 0, hi = N_PHASES; void* args[] = {&p, &lo, &hi};
    hipError_t e = hipLaunchCooperativeKernel((const void*)k_mega, dim3(grid), dim3(NWAVES * 64), args, LDS_BYTES, stream);
    if (e != hipSuccess) fprintf(stderr, "cooperative launch failed: %s (grid %d)\n", hipGetErrorString(e), grid);
#else
    for (int ph = 0; ph < N_PHASES; ++ph) hipLaunchKernelGGL(k_mega, dim3(grid), dim3(NWAVES * 64), LDS_BYTES, stream, P, ph, ph + 1);
#endif
}
#endif
extern "C" void kernel_launch(void* const* d_in, const int* in_sizes, int n_in, void* d_out, int out_size, void* d_ws, size_t ws_size, hipStream_t stream) {
    static int ok = 0;
    if (ok == 0) {
        ok = 1;
        if (n_in != 12 || in_sizes[0] != M * DM || in_sizes[2] != DM * NIN || out_size != M * DM || ws_size < WS_END) {
            fprintf(stderr, "kernel_launch: unexpected shapes (n_in %d in0 %d in2 %d out %d ws %zu); nothing launched\n", n_in, n_in > 0 ? in_sizes[0] : -1, n_in > 2 ? in_sizes[2] : -1, out_size, ws_size); ok = -1; }
    }
    if (ok < 0) return;
    Ptrs P{};
    P.x = (const float*)d_in[0]; P.norm_w = (const float*)d_in[1]; P.w_in = (const float*)d_in[2]; P.w_ret_up = (const float*)d_in[3]; P.w_diff_up = (const float*)d_in[4];
    P.w_out = (const float*)d_in[5]; P.lq1 = (const float*)d_in[6]; P.lk1 = (const float*)d_in[7]; P.lq2 = (const float*)d_in[8]; P.lk2 = (const float*)d_in[9];
    P.subln_w = (const float*)d_in[10]; P.final_w = (const float*)d_in[11]; P.out = (float*)d_out; P.ws = (unsigned char*)d_ws;
#if MODE == 0
    naive::launch_all(P, stream);
#else
    opt_launch(P, stream);
#endif
}
```
